# Optimizing an MI355X kernel written in HIP

```python
import math
import jax, jax.numpy as jnp
from jax import lax
import numpy as np

D_MODEL = 1024
BATCH = 16
SEQ = 2048
DEPTH = 2

CHUNK = 64
N_MIXERS = 2
D_FF = 2816
PLE_DIM = 256
S5_GROUP = 16
S5_GROUPS = D_MODEL // S5_GROUP
S5_STATE = 64
SB_HEAD_DIM = 64
SB_HEADS = D_MODEL // SB_HEAD_DIM
Q_BLOCK = 128
N_A = (DEPTH + 1) // 2
N_B = DEPTH // 2
EPS = 1e-6
DT_MIN = 1e-3
DT_MAX = 1e-1

kernel_name = 'hybrid_s5_stickbreaking_macaron'


def rmsnorm(x, g):
    xf = x.astype(jnp.float32)
    y = xf * lax.rsqrt(jnp.mean(xf * xf, axis=-1, keepdims=True) + EPS)
    return (y * g.astype(jnp.float32)).astype(x.dtype)


def swiglu(x, w1, w3, w2):
    return (jax.nn.silu(x @ w1) * (x @ w3)) @ w2


def _cmul(ar, ai, br, bi):
    return ar * br - ai * bi, ar * bi + ai * br


def _s5_combine(e1, e2):
    a1r, a1i, b1r, b1i = e1
    a2r, a2i, b2r, b2i = e2
    ar, ai = _cmul(a2r, a2i, a1r, a1i)
    cr, ci = _cmul(a2r, a2i, b1r, b1i)
    return ar, ai, cr + b2r, ci + b2i


def s5_mixer(h, w_in, a_re, a_im, log_dt, b_re, b_im, c_re, c_im, d_skip, w_glu):
    bsz, seq_len, _ = h.shape
    f32 = jnp.float32
    u = h @ w_in
    ug = u.astype(f32).reshape(bsz, seq_len, S5_GROUPS, S5_GROUP)
    lam_re = jnp.minimum(a_re.astype(f32), -1e-4)
    lam_im = a_im.astype(f32)
    dt = jnp.exp(log_dt.astype(f32))[:, None]
    mag = jnp.exp(lam_re * dt)
    abar_re = mag * jnp.cos(lam_im * dt)
    abar_im = mag * jnp.sin(lam_im * dt)
    den = lam_re * lam_re + lam_im * lam_im
    nr = abar_re - 1.0
    ni = abar_im
    fr = (nr * lam_re + ni * lam_im) / den
    fi = (ni * lam_re - nr * lam_im) / den
    bre = b_re.astype(f32)
    bim = b_im.astype(f32)
    bbar_re = fr[..., None] * bre - fi[..., None] * bim
    bbar_im = fr[..., None] * bim + fi[..., None] * bre
    bu_re = jnp.einsum('blgh,gph->blgp', ug, bbar_re)
    bu_im = jnp.einsum('blgh,gph->blgp', ug, bbar_im)
    a_seq_re = jnp.broadcast_to(abar_re, (1, seq_len, S5_GROUPS, S5_STATE))
    a_seq_im = jnp.broadcast_to(abar_im, (1, seq_len, S5_GROUPS, S5_STATE))
    _, _, s_re, s_im = lax.associative_scan(
        _s5_combine, (a_seq_re, a_seq_im, bu_re, bu_im), axis=1)
    y = (jnp.einsum('blgp,ghp->blgh', s_re, c_re.astype(f32))
         - jnp.einsum('blgp,ghp->blgh', s_im, c_im.astype(f32)))
    y = y.reshape(bsz, seq_len, D_MODEL) + d_skip.astype(f32) * u.astype(f32)
    z = jax.nn.gelu(y).astype(h.dtype)
    z_out, z_gate = jnp.split(z @ w_glu, 2, axis=-1)
    return z_out * jax.nn.sigmoid(z_gate)


def stick_breaking_mixer(h, w_qkv, w_o):
    bsz, seq_len, _ = h.shape
    qkv = (h @ w_qkv).reshape(bsz, seq_len, 3, SB_HEADS, SB_HEAD_DIM)
    q = qkv[:, :, 0].transpose(0, 2, 1, 3)
    k = qkv[:, :, 1].transpose(0, 2, 1, 3)
    v = qkv[:, :, 2].transpose(0, 2, 1, 3)
    scale = SB_HEAD_DIM ** -0.5
    outs = []
    for blk in range(seq_len // Q_BLOCK):
        start = blk * Q_BLOCK
        end = start + Q_BLOCK
        qb = q[:, :, start:end]
        kb = k[:, :, :end]
        vb = v[:, :, :end]
        z = jnp.einsum('bhqd,bhkd->bhqk', qb, kb).astype(jnp.float32) * scale
        t_pos = start + jnp.arange(Q_BLOCK)[:, None]
        s_pos = jnp.arange(end)[None, :]
        strict = s_pos < t_pos
        log_keep = jnp.where(strict, jax.nn.log_sigmoid(-z), 0.0)
        later = lax.cumsum(log_keep, axis=3, reverse=True) - log_keep
        att = jnp.where(strict, jnp.exp(jax.nn.log_sigmoid(z) + later), 0.0)
        outs.append(jnp.einsum('bhqk,bhkd->bhqd', att.astype(vb.dtype), vb))
    o = jnp.concatenate(outs, axis=2).transpose(0, 2, 1, 3).reshape(bsz, seq_len, D_MODEL)
    return o @ w_o


def setup_inputs(seed: int = 0) -> dict:
    key = jax.random.key(seed)
    ks = jax.random.split(key, 32)
    f32 = jnp.float32
    nrm = lambda k, shape, s: jax.random.normal(k, shape, f32) * s
    gain = lambda k, shape: 1.0 + 0.02 * jax.random.normal(k, shape, f32)
    d_in = D_MODEL ** -0.5
    a_im0 = math.pi * jnp.arange(S5_STATE, dtype=f32)
    return {
        'x': jax.random.normal(ks[0], (BATCH, SEQ, D_MODEL), f32),
        'p': jax.random.normal(ks[1], (DEPTH, BATCH, SEQ, PLE_DIM), f32),
        'ffn1_norm': gain(ks[2], (DEPTH, D_MODEL)),
        'ffn1_w1': nrm(ks[3], (DEPTH, D_MODEL, D_FF), d_in),
        'ffn1_w3': nrm(ks[4], (DEPTH, D_MODEL, D_FF), d_in),
        'ffn1_w2': nrm(ks[5], (DEPTH, D_FF, D_MODEL), D_FF ** -0.5),
        'mix_norm': gain(ks[6], (DEPTH, D_MODEL)),
        'ffn2_norm': gain(ks[7], (DEPTH, D_MODEL)),
        'ffn2_w1': nrm(ks[8], (DEPTH, D_MODEL, D_FF), d_in),
        'ffn2_w3': nrm(ks[9], (DEPTH, D_MODEL, D_FF), d_in),
        'ffn2_w2': nrm(ks[10], (DEPTH, D_FF, D_MODEL), D_FF ** -0.5),
        'ple_norm': gain(ks[11], (DEPTH, D_MODEL)),
        'ple_proj': nrm(ks[12], (DEPTH, PLE_DIM, D_MODEL), PLE_DIM ** -0.5),
        'ple_gate': nrm(ks[13], (DEPTH, D_MODEL, D_MODEL), d_in),
        's5_w_in': nrm(ks[14], (N_A, D_MODEL, D_MODEL), d_in),
        's5_a_re': -0.5 + 0.01 * jax.random.normal(ks[15], (N_A, S5_GROUPS, S5_STATE), f32),
        's5_a_im': a_im0 + 0.01 * jax.random.normal(ks[16], (N_A, S5_GROUPS, S5_STATE), f32),
        's5_log_dt': jax.random.uniform(ks[17], (N_A, S5_GROUPS), f32,
                                        math.log(DT_MIN), math.log(DT_MAX)),
        's5_b_re': nrm(ks[18], (N_A, S5_GROUPS, S5_STATE, S5_GROUP), (2 * S5_GROUP) ** -0.5),
        's5_b_im': nrm(ks[19], (N_A, S5_GROUPS, S5_STATE, S5_GROUP), (2 * S5_GROUP) ** -0.5),
        's5_c_re': nrm(ks[20], (N_A, S5_GROUPS, S5_GROUP, S5_STATE), S5_STATE ** -0.5),
        's5_c_im': nrm(ks[21], (N_A, S5_GROUPS, S5_GROUP, S5_STATE), S5_STATE ** -0.5),
        's5_d': jax.random.normal(ks[22], (N_A, D_MODEL), f32),
        's5_w_glu': nrm(ks[23], (N_A, D_MODEL, 2 * D_MODEL), d_in),
        'sb_w_qkv': nrm(ks[24], (N_B, D_MODEL, 3 * D_MODEL), d_in),
        'sb_w_o': nrm(ks[25], (N_B, D_MODEL, D_MODEL), d_in),
        'final_norm': gain(ks[26], (D_MODEL,)),
    }


def reference(x, p, ffn1_norm, ffn1_w1, ffn1_w3, ffn1_w2, mix_norm, ffn2_norm,
              ffn2_w1, ffn2_w3, ffn2_w2, ple_norm, ple_proj, ple_gate,
              s5_w_in, s5_a_re, s5_a_im, s5_log_dt, s5_b_re, s5_b_im,
              s5_c_re, s5_c_im, s5_d, s5_w_glu, sb_w_qkv, sb_w_o, final_norm):
    h = x
    for i in range(DEPTH):
        h = h + 0.5 * swiglu(rmsnorm(h, ffn1_norm[i]), ffn1_w1[i], ffn1_w3[i], ffn1_w2[i])
        hn = rmsnorm(h, mix_norm[i])
        j = i // N_MIXERS
        if i % N_MIXERS == 0:
            m = s5_mixer(hn, s5_w_in[j], s5_a_re[j], s5_a_im[j], s5_log_dt[j],
                         s5_b_re[j], s5_b_im[j], s5_c_re[j], s5_c_im[j],
                         s5_d[j], s5_w_glu[j])
        else:
            m = stick_breaking_mixer(hn, sb_w_qkv[j], sb_w_o[j])
        h = h + m
        h = h + 0.5 * swiglu(rmsnorm(h, ffn2_norm[i]), ffn2_w1[i], ffn2_w3[i], ffn2_w2[i])
        gate = jax.nn.sigmoid(rmsnorm(h, ple_norm[i]) @ ple_gate[i])
        h = h + (p[i].astype(h.dtype) @ ple_proj[i]) * gate
    return rmsnorm(h, final_norm)
```

```cpp
#include <hip/hip_runtime.h>
#include <hip/hip_cooperative_groups.h>
#include <cstdio>
#include <cstdint>
namespace cg = cooperative_groups;

#ifndef MK_MULTI
#define MK_MULTI 0
#endif

#define LAS __attribute__((address_space(3)))
typedef unsigned short bf16_t;
typedef short bf16x8 __attribute__((ext_vector_type(8)));
typedef float f32x4 __attribute__((ext_vector_type(4)));
typedef float f32x2 __attribute__((ext_vector_type(2)));
typedef float f32x16 __attribute__((ext_vector_type(16)));
typedef unsigned u32x4 __attribute__((ext_vector_type(4)));
typedef unsigned u32x2 __attribute__((ext_vector_type(2)));

constexpr int NB = 16, SEQ = 2048, T = NB * SEQ, D = 1024, FF = 2816, PD = 256;
constexpr int NG = 64, NCH = 128, CROWS = NB * NCH, A5K = 384;
constexpr float EPS = 1e-6f;
constexpr float QSCALE = 0.125f * 1.4426950408889634f;
constexpr int NTHREADS = 512, NWAVES = 8;

constexpr size_t MiB = 1u << 20;
constexpr size_t WS_WUP = 1 * MiB;
constexpr size_t SZ_WUP = 11 * MiB;
constexpr size_t WS_WDN = WS_WUP + 4 * SZ_WUP;
constexpr size_t SZ_WDN = 11 * MiB / 2;
constexpr size_t WS_WG = WS_WDN + 4 * SZ_WDN;
constexpr size_t WS_WP = WS_WG + 4 * MiB;
constexpr size_t WS_WIN = WS_WP + 1 * MiB;
constexpr size_t WS_WGLU = WS_WIN + 2 * MiB;
constexpr size_t WS_WQKV = WS_WGLU + 4 * MiB;
constexpr size_t WS_WO = WS_WQKV + 6 * MiB;
constexpr size_t WS_BST = WS_WO + 2 * MiB;
constexpr size_t WS_BCAT = WS_BST + 8 * MiB;
constexpr size_t WS_AB16 = WS_BCAT + 12 * MiB;
constexpr size_t WS_SSQ = 108 * MiB;
constexpr size_t WS_HB = 116 * MiB;
constexpr size_t WS_PB = 180 * MiB;
constexpr size_t WS_BIG = 212 * MiB;
constexpr size_t WS_EXTRA = 388 * MiB;
constexpr size_t WS_END = 452 * MiB;

constexpr int LDS_BYTES = 131072 + 1024;

__device__ __forceinline__ unsigned cvt_pk_bf16(float lo, float hi) { unsigned r; asm volatile("v_cvt_pk_bf16_f32 %0, %1, %2" : "=v"(r) : "v"(lo), "v"(hi)); return r; }
__device__ __forceinline__ float bf_lo(unsigned w) { return __uint_as_float(w << 16); }
__device__ __forceinline__ float bf_hi(unsigned w) { return __uint_as_float(w & 0xffff0000u); }
__device__ __forceinline__ float fast_rcp(float x) { return __builtin_amdgcn_rcpf(x); }
__device__ __forceinline__ float sigmoidf_(float x) { return fast_rcp(1.0f + __expf(-x)); }
__device__ __forceinline__ int otid() { int t = threadIdx.x; asm volatile("" : "+v"(t)); return t; }
__device__ __forceinline__ float wave_sum(float v) {
#pragma unroll
    for (int o = 1; o < 64; o <<= 1) v += __shfl_xor(v, o);
    return v;
}

namespace pg8 {
constexpr int BM = 256, BK = 64, HALF = 128, HTB = HALF * BK * 2, STAGE_BYTES = 8 * HTB, NXCD = 8, WGM = 8;
__host__ __device__ __forceinline__ int lds_byte(int r, int c) { const int st = (r >> 4) * 2 + (c >> 5), rr = r & 15, cc = c & 31, ob = rr * 64 + cc * 2; return st * 1024 + (ob ^ (((ob >> 9) & 1) << 5)); }
__host__ __device__ __forceinline__ void stage_rc(int b, int& R, int& C) { const int st = b / 1024, sb = b % 1024, swz = sb ^ (((sb >> 9) & 1) << 5); R = (st >> 1) * 16 + swz / 64; C = (st & 1) * 32 + (swz % 64) / 2; }
__host__ __device__ __forceinline__ int perm32(int rho) { const int n = rho >> 4, i = rho & 15; return 8 * (i >> 2) + 4 * n + (i & 3); }

struct Unit { int pm, pn, grp; };
struct Gemm { const bf16_t* A; const bf16_t* Bt; int lda, ldb, K; size_t gsA, gsB; };

struct Order {
    int nM, nN, nwg, G, c, ngrp;
    __device__ void init(int M, int N, int ngrp_, int G_, int c_) { nM = M / BM; nN = N / BM; nwg = nM * nN; G = G_; c = c_; ngrp = ngrp_; }
    __device__ bool next(int i, Unit& u) const {
        const long L = (long)i * G + c; if (L >= (long)nwg * ngrp) return false;
        if (ngrp > 1) { u.grp = (int)(L / nwg); const int r = (int)(L % nwg); u.pm = r / nN; u.pn = r % nN; return true; }
        u.grp = 0;
        int wgid = (int)L; { const int q = nwg / NXCD, r = nwg % NXCD, xcd = wgid % NXCD, off = wgid / NXCD; wgid = (xcd < r ? xcd * (q + 1) : r * (q + 1) + (xcd - r) * q) + off; }
        const int nig = WGM * nN, gid = wgid / nig, fm = gid * WGM, gsz = (nM - fm) < WGM ? (nM - fm) : WGM;
        u.pm = fm + ((wgid % nig) % gsz); u.pn = (wgid % nig) / gsz; return true;
    }
};

template <class Epi>
__device__ __forceinline__ void gemm_phase(LAS unsigned char* lds, const Gemm g, const Order& S, const Epi& E) {
    int tid_ = threadIdx.x; asm volatile("" : "+v"(tid_));
    const int tid = tid_, wid = __builtin_amdgcn_readfirstlane(tid >> 6), lane = tid & 63, wr = wid >> 2, wc = wid & 3, fr = lane & 15, fq = lane >> 4;
    int nt_ = g.K / BK; asm volatile("" : "+s"(nt_)); const int nt = nt_;
    unsigned voffA[2], voffB[2];
#pragma unroll
    for (int i = 0; i < 2; ++i) { int R, C; stage_rc(tid * 16 + i * 8192, R, C); const int Rb = (R & ~31) + perm32(R & 31);
        voffA[i] = (unsigned)(R * g.lda + C) * 2u; voffB[i] = (unsigned)(Rb * g.ldb + C) * 2u; }
    const size_t kstep = (size_t)(BK * 2);
    const size_t hstepA = (size_t)HALF * g.lda * 2, hstepB = (size_t)HALF * g.ldb * 2;
    const size_t tstepA = 2 * hstepA, tstepB = 2 * hstepB;
    const unsigned ldsw = (unsigned)wid * 1024u;
    const int aoff = lds_byte(wr * 64 + fr, fq * 8), boff = lds_byte(wc * 32 + fr, fq * 8);
#define PG8_SA(b, h) (((b) * 2 + (h)) * HTB)
#define PG8_SB(b, h) ((4 + (b) * 2 + (h)) * HTB)
#define PG8_STAGE(bufoff, gbase, voff) do { _Pragma("unroll") for (int _i = 0; _i < 2; ++_i) \
        __builtin_amdgcn_global_load_lds((const unsigned*)((const char*)(gbase) + (voff)[_i]), (LAS unsigned*)(lds + (bufoff) + ldsw + _i * 8192), 16, 0, 0); } while (0)
#define PG8_LDA(dst, b, h) do { _Pragma("unroll") for (int m = 0; m < 4; ++m) _Pragma("unroll") for (int k = 0; k < 2; ++k) dst[m][k] = *(const LAS bf16x8*)(lds + PG8_SA(b, h) + aoff + m * 2048 + k * 1024); } while (0)
#define PG8_LDB(dst, b, h) do { _Pragma("unroll") for (int n = 0; n < 2; ++n) _Pragma("unroll") for (int k = 0; k < 2; ++k) dst[n][k] = *(const LAS bf16x8*)(lds + PG8_SB(b, h) + boff + n * 2048 + k * 1024); } while (0)
#define PG8_MMA(ai, bj, At, Bt) do { __builtin_amdgcn_s_setprio(1); _Pragma("unroll") for (int m = 0; m < 4; ++m) _Pragma("unroll") for (int n = 0; n < 2; ++n) _Pragma("unroll") for (int k = 0; k < 2; ++k) \
        acc[ai][bj][m][n] = __builtin_amdgcn_mfma_f32_16x16x32_bf16(Bt[n][k], At[m][k], acc[ai][bj][m][n], 0, 0, 0); __builtin_amdgcn_s_setprio(0); } while (0)
#define PG8_WAIT_V(n) asm volatile("s_waitcnt vmcnt(" #n ")" ::: "memory")
#define PG8_WAIT_L(n) asm volatile("s_waitcnt lgkmcnt(" #n ")" ::: "memory")
#define PG8_BAR __builtin_amdgcn_s_barrier()
#define PG8_SCHED __builtin_amdgcn_sched_barrier(0)
    Unit cur, nxt; int ui = 0;
    if (!S.next(0, cur)) return;
    f32x4 acc[2][2][4][2];
#pragma unroll
    for (int a = 0; a < 2; ++a)
#pragma unroll
        for (int b = 0; b < 2; ++b)
#pragma unroll
            for (int m = 0; m < 4; ++m)
#pragma unroll
                for (int n = 0; n < 2; ++n) acc[a][b][m][n] = (f32x4){0.f, 0.f, 0.f, 0.f};
    bf16x8 At[4][2], B0[2][2], B1[2][2];
    const char* cA = (const char*)g.A + (size_t)cur.grp * g.gsA + (size_t)cur.pm * tstepA;
    const char* cB = (const char*)g.Bt + (size_t)cur.grp * g.gsB + (size_t)cur.pn * tstepB;
    PG8_STAGE(PG8_SB(0, 0), cB, voffB); PG8_STAGE(PG8_SB(0, 1), cB + hstepB, voffB); PG8_STAGE(PG8_SA(0, 0), cA, voffA); PG8_STAGE(PG8_SA(0, 1), cA + hstepA, voffA);
    if (wr == 1) PG8_BAR;
    PG8_WAIT_V(2); PG8_BAR;
    PG8_STAGE(PG8_SB(1, 0), cB + kstep, voffB); PG8_STAGE(PG8_SA(1, 0), cA + kstep, voffA); PG8_STAGE(PG8_SB(1, 1), cB + hstepB + kstep, voffB);
    PG8_WAIT_V(6); PG8_BAR;
    for (;;) {
        const bool has_next = S.next(ui + 1, nxt);
        const char* nA = has_next ? (const char*)g.A + (size_t)nxt.grp * g.gsA + (size_t)nxt.pm * tstepA : cA;
        const char* nB = has_next ? (const char*)g.Bt + (size_t)nxt.grp * g.gsB + (size_t)nxt.pn * tstepB : cB;
        for (int t = 0; t < nt; t += 2) {
            const bool last = (t == nt - 2);
            const char* a1 = cA + (size_t)(t + 1) * kstep;
            const char* a2 = last ? nA : cA + (size_t)(t + 2) * kstep; const char* b2 = last ? nB : cB + (size_t)(t + 2) * kstep;
            const char* a3 = a2 + kstep; const char* b3 = b2 + kstep;
            PG8_LDB(B0, 0, 0); PG8_LDB(B1, 0, 1); PG8_SCHED; PG8_LDA(At, 0, 0); PG8_STAGE(PG8_SA(1, 1), a1 + hstepA, voffA);
            PG8_WAIT_V(8); PG8_WAIT_L(0); PG8_BAR; PG8_MMA(0, 0, At, B0); PG8_MMA(0, 1, At, B1); PG8_BAR; PG8_SCHED;
            PG8_LDA(At, 0, 1); PG8_STAGE(PG8_SB(0, 0), b2, voffB); PG8_STAGE(PG8_SB(0, 1), b2 + hstepB, voffB); PG8_STAGE(PG8_SA(0, 0), a2, voffA);
            PG8_WAIT_V(8); PG8_WAIT_L(0); PG8_BAR; PG8_MMA(1, 0, At, B0); PG8_MMA(1, 1, At, B1); PG8_BAR; PG8_SCHED;
            PG8_LDB(B0, 1, 0); PG8_LDB(B1, 1, 1); PG8_SCHED; PG8_LDA(At, 1, 0); PG8_STAGE(PG8_SA(0, 1), a2 + hstepA, voffA);
            PG8_WAIT_V(8); PG8_WAIT_L(0); PG8_BAR; PG8_MMA(0, 0, At, B0); PG8_MMA(0, 1, At, B1); PG8_BAR; PG8_SCHED;
            PG8_LDA(At, 1, 1); PG8_STAGE(PG8_SB(1, 0), b3, voffB); PG8_STAGE(PG8_SB(1, 1), b3 + hstepB, voffB); PG8_STAGE(PG8_SA(1, 0), a3, voffA);
            PG8_WAIT_V(8); PG8_WAIT_L(0); PG8_BAR; PG8_MMA(1, 0, At, B0); PG8_MMA(1, 1, At, B1); PG8_BAR; PG8_SCHED;
        }
        if (wr == 0) PG8_BAR;
        { int fr_ = fr, fq_ = fq; asm volatile("" : "+v"(fr_), "+v"(fq_));
          E(acc, cur, wr, wc, fr_, fq_); }
        if (!has_next) break;
#pragma unroll
        for (int a = 0; a < 2; ++a)
#pragma unroll
            for (int b = 0; b < 2; ++b)
#pragma unroll
                for (int m = 0; m < 4; ++m)
#pragma unroll
                    for (int n = 0; n < 2; ++n) acc[a][b][m][n] = (f32x4){0.f, 0.f, 0.f, 0.f};
        cur = nxt; cA = nA; cB = nB; ++ui;
        if (wr == 1) PG8_BAR;
    }
    PG8_WAIT_V(0);
    PG8_BAR;
#undef PG8_SA
#undef PG8_SB
#undef PG8_STAGE
#undef PG8_LDA
#undef PG8_LDB
#undef PG8_MMA
#undef PG8_WAIT_V
#undef PG8_WAIT_L
#undef PG8_BAR
#undef PG8_SCHED
}

typedef f32x4 Acc[2][2][4][2];

template <int NP> __device__ __forceinline__ void load_rstd(const float* P, int row0, int fq, float (&rs)[2][4]) {
#pragma unroll
    for (int ai = 0; ai < 2; ++ai)
#pragma unroll
        for (int m = 0; m < 4; ++m) {
            const f32x4* p = (const f32x4*)(P + (size_t)(row0 + 128 * ai + 16 * m) * NP) + fq;
            f32x4 v = p[0]; float s = (v[0] + v[1]) + (v[2] + v[3]);
            if (NP == 32) { f32x4 w = p[4]; s += (w[0] + w[1]) + (w[2] + w[3]); }
            s += __shfl_xor(s, 16); s += __shfl_xor(s, 32);
            rs[ai][m] = rsqrtf(s * (1.0f / D) + EPS);
        }
}
__device__ __forceinline__ u32x4 pack8(f32x4 a, f32x4 b) { u32x4 w; w.x = cvt_pk_bf16(a[0], a[1]); w.y = cvt_pk_bf16(a[2], a[3]); w.z = cvt_pk_bf16(b[0], b[1]); w.w = cvt_pk_bf16(b[2], b[3]); return w; }

template <int NPIN> struct EpiUp {
    bf16_t* O; const float* P;
    __device__ __forceinline__ void operator()(const Acc& acc, const Unit& u, int wr, int wc, int fr, int fq) const {
        const int row0 = u.pm * BM + wr * 64 + fr; float rs[2][4]; load_rstd<NPIN>(P, row0, fq, rs);
        const int col0 = u.pn * 128 + wc * 32 + 8 * fq;
#pragma unroll
        for (int ai = 0; ai < 2; ++ai)
#pragma unroll
            for (int m = 0; m < 4; ++m) { const float r = rs[ai][m]; f32x4 o[2];
#pragma unroll
                for (int n = 0; n < 2; ++n)
#pragma unroll
                    for (int c = 0; c < 4; ++c) { const float a = acc[ai][0][m][n][c] * r, b = acc[ai][1][m][n][c] * r; o[n][c] = a * sigmoidf_(a) * b; }
                *(u32x4*)(O + (size_t)(row0 + ai * HALF + m * 16) * FF + col0) = pack8(o[0], o[1]); }
    }
};
struct EpiRes {
    const float* hin; float* hout; bf16_t* hb; float* Pout; float scale;
    __device__ __forceinline__ void operator()(const Acc& acc, const Unit& u, int wr, int wc, int fr, int fq) const {
        const int row0 = u.pm * BM + wr * 64 + fr;
#pragma unroll
        for (int ai = 0; ai < 2; ++ai)
#pragma unroll
            for (int m = 0; m < 4; ++m) { const int row = row0 + ai * HALF + m * 16; float ss = 0.f;
#pragma unroll
                for (int bj = 0; bj < 2; ++bj) { const size_t off = (size_t)row * D + u.pn * BM + bj * HALF + wc * 32 + 8 * fq;
                    f32x4 h0 = *(const f32x4*)(hin + off), h1 = *(const f32x4*)(hin + off + 4);
                    h0 = h0 + acc[ai][bj][m][0] * scale; h1 = h1 + acc[ai][bj][m][1] * scale;
                    *(f32x4*)(hout + off) = h0; *(f32x4*)(hout + off + 4) = h1; *(u32x4*)(hb + off) = pack8(h0, h1);
                    ss += (h0[0] * h0[0] + h0[1] * h0[1]) + (h0[2] * h0[2] + h0[3] * h0[3]) + (h1[0] * h1[0] + h1[1] * h1[1]) + (h1[2] * h1[2] + h1[3] * h1[3]); }
                ss += __shfl_xor(ss, 16); ss += __shfl_xor(ss, 32);
                if (fq == 0) Pout[(size_t)row * 16 + u.pn * 4 + wc] = ss; }
    }
};
struct EpiGlu {
    const float* hin; float* hout; bf16_t* hb; float* Pout;
    __device__ __forceinline__ void operator()(const Acc& acc, const Unit& u, int wr, int wc, int fr, int fq) const {
        const int row0 = u.pm * BM + wr * 64 + fr;
#pragma unroll
        for (int ai = 0; ai < 2; ++ai)
#pragma unroll
            for (int m = 0; m < 4; ++m) { const int row = row0 + ai * HALF + m * 16; const size_t off = (size_t)row * D + u.pn * 128 + wc * 32 + 8 * fq;
                f32x4 h0 = *(const f32x4*)(hin + off), h1 = *(const f32x4*)(hin + off + 4);
#pragma unroll
                for (int c = 0; c < 4; ++c) { h0[c] += acc[ai][0][m][0][c] * sigmoidf_(acc[ai][1][m][0][c]); h1[c] += acc[ai][0][m][1][c] * sigmoidf_(acc[ai][1][m][1][c]); }
                *(f32x4*)(hout + off) = h0; *(f32x4*)(hout + off + 4) = h1; *(u32x4*)(hb + off) = pack8(h0, h1);
                float ss = (h0[0] * h0[0] + h0[1] * h0[1]) + (h0[2] * h0[2] + h0[3] * h0[3]) + (h1[0] * h1[0] + h1[1] * h1[1]) + (h1[2] * h1[2] + h1[3] * h1[3]);
                ss += __shfl_xor(ss, 16); ss += __shfl_xor(ss, 32);
                if (fq == 0) Pout[(size_t)row * 32 + u.pn * 4 + wc] = ss; }
    }
};
template <int NPIN> struct EpiPle {
    const float* hin; float* hout; bf16_t* hb; const bf16_t* pp; const float* Pin; float* Pout;
    __device__ __forceinline__ void operator()(const Acc& acc, const Unit& u, int wr, int wc, int fr, int fq) const {
        const int row0 = u.pm * BM + wr * 64 + fr; float rs[2][4]; load_rstd<NPIN>(Pin, row0, fq, rs);
#pragma unroll
        for (int ai = 0; ai < 2; ++ai)
#pragma unroll
            for (int m = 0; m < 4; ++m) { const int row = row0 + ai * HALF + m * 16; float ss = 0.f; const float r = rs[ai][m];
#pragma unroll
                for (int bj = 0; bj < 2; ++bj) { const size_t off = (size_t)row * D + u.pn * BM + bj * HALF + wc * 32 + 8 * fq;
                    f32x4 h0 = *(const f32x4*)(hin + off), h1 = *(const f32x4*)(hin + off + 4); const u32x4 pw = *(const u32x4*)(pp + off);
                    h0[0] += bf_lo(pw.x) * sigmoidf_(acc[ai][bj][m][0][0] * r); h0[1] += bf_hi(pw.x) * sigmoidf_(acc[ai][bj][m][0][1] * r);
                    h0[2] += bf_lo(pw.y) * sigmoidf_(acc[ai][bj][m][0][2] * r); h0[3] += bf_hi(pw.y) * sigmoidf_(acc[ai][bj][m][0][3] * r);
                    h1[0] += bf_lo(pw.z) * sigmoidf_(acc[ai][bj][m][1][0] * r); h1[1] += bf_hi(pw.z) * sigmoidf_(acc[ai][bj][m][1][1] * r);
                    h1[2] += bf_lo(pw.w) * sigmoidf_(acc[ai][bj][m][1][2] * r); h1[3] += bf_hi(pw.w) * sigmoidf_(acc[ai][bj][m][1][3] * r);
                    *(f32x4*)(hout + off) = h0; *(f32x4*)(hout + off + 4) = h1; *(u32x4*)(hb + off) = pack8(h0, h1);
                    ss += (h0[0] * h0[0] + h0[1] * h0[1]) + (h0[2] * h0[2] + h0[3] * h0[3]) + (h1[0] * h1[0] + h1[1] * h1[1]) + (h1[2] * h1[2] + h1[3] * h1[3]); }
                ss += __shfl_xor(ss, 16); ss += __shfl_xor(ss, 32);
                if (fq == 0) Pout[(size_t)row * 16 + u.pn * 4 + wc] = ss; }
    }
};
struct EpiPlain {
    bf16_t* O; int ldc;
    __device__ __forceinline__ void operator()(const Acc& acc, const Unit& u, int wr, int wc, int fr, int fq) const {
        const int row0 = u.pm * BM + wr * 64 + fr;
#pragma unroll
        for (int ai = 0; ai < 2; ++ai)
#pragma unroll
            for (int m = 0; m < 4; ++m)
#pragma unroll
                for (int bj = 0; bj < 2; ++bj)
                    *(u32x4*)(O + (size_t)(row0 + ai * HALF + m * 16) * ldc + u.pn * BM + bj * HALF + wc * 32 + 8 * fq) = pack8(acc[ai][bj][m][0], acc[ai][bj][m][1]);
    }
};
template <int NPIN> struct EpiWin {
    bf16_t* A5; const float* P;
    __device__ __forceinline__ void operator()(const Acc& acc, const Unit& u, int wr, int wc, int fr, int fq) const {
        const int row0 = u.pm * BM + wr * 64 + fr; float rs[2][4]; load_rstd<NPIN>(P, row0, fq, rs);
#pragma unroll
        for (int ai = 0; ai < 2; ++ai)
#pragma unroll
            for (int m = 0; m < 4; ++m) { const int tok = row0 + ai * HALF + m * 16; const float r = rs[ai][m];
#pragma unroll
                for (int bj = 0; bj < 2; ++bj) { const int ch = u.pn * BM + bj * HALF + wc * 32 + 8 * fq; const int gI = ch >> 4, hi0 = ch & 15;
                    *(u32x4*)(A5 + ((size_t)gI * CROWS + (tok >> 4)) * A5K + (tok & 15) * 16 + hi0) = pack8(acc[ai][bj][m][0] * r, acc[ai][bj][m][1] * r); } }
    }
};
struct EpiSloc {
    float* S;
    __device__ __forceinline__ void operator()(const Acc& acc, const Unit& u, int wr, int wc, int fr, int fq) const {
        const int row0 = u.pm * BM + wr * 64 + fr;
#pragma unroll
        for (int ai = 0; ai < 2; ++ai)
#pragma unroll
            for (int m = 0; m < 4; ++m) { float* o = S + ((size_t)u.grp * CROWS + row0 + ai * HALF + m * 16) * 128 + wc * 32 + 8 * fq;
                *(f32x4*)o = acc[ai][0][m][0]; *(f32x4*)(o + 4) = acc[ai][0][m][1]; }
    }
};
struct EpiY {
    const bf16_t* A5; const float* dsk; bf16_t* Z;
    __device__ __forceinline__ void operator()(const Acc& acc, const Unit& u, int wr, int wc, int fr, int fq) const {
        const int row0 = u.pm * BM + wr * 64 + fr; const int gI = u.grp;
#pragma unroll
        for (int bj = 0; bj < 2; ++bj) { const int n0 = bj * HALF + wc * 32 + 8 * fq, tl = n0 >> 4, ho0 = n0 & 15;
            const f32x4 d0 = *(const f32x4*)(dsk + gI * 16 + ho0), d1 = *(const f32x4*)(dsk + gI * 16 + ho0 + 4);
#pragma unroll
            for (int ai = 0; ai < 2; ++ai)
#pragma unroll
                for (int m = 0; m < 4; ++m) { const int R = row0 + ai * HALF + m * 16;
                    const u32x4 uw = *(const u32x4*)(A5 + ((size_t)gI * CROWS + R) * A5K + n0);
                    f32x4 y0 = acc[ai][bj][m][0], y1 = acc[ai][bj][m][1];
                    y0[0] += d0[0] * bf_lo(uw.x); y0[1] += d0[1] * bf_hi(uw.x); y0[2] += d0[2] * bf_lo(uw.y); y0[3] += d0[3] * bf_hi(uw.y);
                    y1[0] += d1[0] * bf_lo(uw.z); y1[1] += d1[1] * bf_hi(uw.z); y1[2] += d1[2] * bf_lo(uw.w); y1[3] += d1[3] * bf_hi(uw.w);
#pragma unroll
                    for (int c = 0; c < 4; ++c) { float x = y0[c]; y0[c] = x * sigmoidf_(1.5957691216f * (x + 0.044715f * x * x * x)); x = y1[c]; y1[c] = x * sigmoidf_(1.5957691216f * (x + 0.044715f * x * x * x)); }
                    *(u32x4*)(Z + (size_t)(R * 16 + tl) * D + gI * 16 + ho0) = pack8(y0, y1);
                    asm volatile("" ::: "memory"); } }
    }
};
template <int NPIN> struct EpiQK {
    bf16_t* Q; bf16_t* Kk; const float* P;
    __device__ __forceinline__ void operator()(const Acc& acc, const Unit& u, int wr, int wc, int fr, int fq) const {
        const int row0 = u.pm * BM + wr * 64 + fr; float rs[2][4]; load_rstd<NPIN>(P, row0, fq, rs);
        bf16_t* base = (u.pn < 4) ? Q : Kk; const float sc = (u.pn < 4) ? QSCALE : 1.0f;
#pragma unroll
        for (int ai = 0; ai < 2; ++ai)
#pragma unroll
            for (int m = 0; m < 4; ++m) { const float r = rs[ai][m] * sc;
#pragma unroll
                for (int bj = 0; bj < 2; ++bj)
                    *(u32x4*)(base + (size_t)(row0 + ai * HALF + m * 16) * D + (u.pn & 3) * BM + bj * HALF + wc * 32 + 8 * fq) = pack8(acc[ai][bj][m][0] * r, acc[ai][bj][m][1] * r); }
    }
};
template <int NPIN> struct EpiVt {
    bf16_t* Vt; const float* P;
    __device__ __forceinline__ void operator()(const Acc& acc, const Unit& u, int wr, int wc, int fr, int fq) const {
        const int lane = fq * 16 + fr; const int row0 = u.pm * BM + wr * 64 + fr;
        float myrs; { const int tok = u.pn * BM + (lane >> 5) * HALF + wc * 32 + (lane & 31); const f32x4* p = (const f32x4*)(P + (size_t)tok * NPIN); float s = 0.f;
#pragma unroll
            for (int j = 0; j < NPIN / 4; ++j) { f32x4 v = p[j]; s += (v[0] + v[1]) + (v[2] + v[3]); }
            myrs = rsqrtf(s * (1.0f / D) + EPS); }
        float rsv[2][8];
#pragma unroll
        for (int bj = 0; bj < 2; ++bj)
#pragma unroll
            for (int e = 0; e < 8; ++e) rsv[bj][e] = __shfl(myrs, bj * 32 + 8 * fq + e);
#pragma unroll
        for (int ai = 0; ai < 2; ++ai)
#pragma unroll
            for (int m = 0; m < 4; ++m)
#pragma unroll
                for (int bj = 0; bj < 2; ++bj) { f32x4 a = acc[ai][bj][m][0], b = acc[ai][bj][m][1];
#pragma unroll
                    for (int c = 0; c < 4; ++c) { a[c] *= rsv[bj][c]; b[c] *= rsv[bj][4 + c]; }
                    *(u32x4*)(Vt + (size_t)(row0 + ai * HALF + m * 16) * T + u.pn * BM + bj * HALF + wc * 32 + 8 * fq) = pack8(a, b); }
    }
};
}

struct Params {
    const float* in[27]; float* out; unsigned char* ws; int ph_lo, ph_hi;
};

__device__ __forceinline__ void transpose_item(const float* W, int K, int N, const float* gain, bf16_t* WT, int mode, int off, LAS float* scr, int item, int lane) {
    const int nblk = N / 32, kb = item / nblk, nb = item % nblk, k0 = 64 * kb, n0 = 32 * nb;
#pragma unroll 8
    for (int i = 0; i < 32; ++i) { const int kk = 2 * i + (lane >> 5); float v = W[(size_t)(k0 + kk) * N + n0 + (lane & 31)]; if (gain) v *= gain[k0 + kk]; scr[kk * 33 + (lane & 31)] = v; }
    asm volatile("s_waitcnt lgkmcnt(0)" ::: "memory");
    const int c = lane & 7;
    int d0;
    if (mode == 0) d0 = n0;
    else if (mode == 1) d0 = (n0 / 128) * 256 + off + (n0 % 128);
    else { const int half = n0 / 1024, cc = n0 % 1024; d0 = (cc / 128) * 256 + half * 128 + (cc % 128); }
#pragma unroll
    for (int j = 0; j < 4; ++j) { const int n = (lane >> 3) + 8 * j; const LAS float* s = scr + (8 * c) * 33 + n;
        u32x4 o; o.x = cvt_pk_bf16(s[0 * 33], s[1 * 33]); o.y = cvt_pk_bf16(s[2 * 33], s[3 * 33]); o.z = cvt_pk_bf16(s[4 * 33], s[5 * 33]); o.w = cvt_pk_bf16(s[6 * 33], s[7 * 33]);
        *(u32x4*)(WT + (size_t)(d0 + n) * K + k0 + 8 * c) = o; }
    asm volatile("s_waitcnt lgkmcnt(0)" ::: "memory");
}

__device__ __forceinline__ void weight_item(const Params& P, int it, LAS float* scr, int lane) {
    unsigned char* ws = P.ws;
    constexpr int IU = (D / 64) * (FF / 32);
    if (it < 12 * IU) {
        const int j = it / IU, r = it % IU, li = j / 6, rr = j % 6, w = rr / 3, t = rr % 3;
        if (t < 2) { const float* src = P.in[(w ? 8 : 3) + t] + (size_t)li * D * FF; const float* gain = P.in[w ? 7 : 2] + li * D;
            transpose_item(src, D, FF, gain, (bf16_t*)(ws + WS_WUP + (size_t)(li * 2 + w) * SZ_WUP), 1, t * 128, scr, r, lane); }
        else { const float* src = P.in[w ? 10 : 5] + (size_t)li * FF * D;
            transpose_item(src, FF, D, nullptr, (bf16_t*)(ws + WS_WDN + (size_t)(li * 2 + w) * SZ_WDN), 0, 0, scr, r, lane); }
        return;
    }
    it -= 12 * IU;
    if (it < 1280) { const int li = it / 640, r2 = it % 640;
        if (r2 < 512) transpose_item(P.in[13] + (size_t)li * D * D, D, D, P.in[11] + li * D, (bf16_t*)(ws + WS_WG + (size_t)li * 2 * MiB), 0, 0, scr, r2, lane);
        else transpose_item(P.in[12] + (size_t)li * PD * D, PD, D, nullptr, (bf16_t*)(ws + WS_WP + (size_t)li * (MiB / 2)), 0, 0, scr, r2 - 512, lane);
        return; }
    it -= 1280;
    if (it < 512) { transpose_item(P.in[14], D, D, P.in[6], (bf16_t*)(ws + WS_WIN), 0, 0, scr, it, lane); return; }
    if (it < 1536) { transpose_item(P.in[23], D, 2 * D, nullptr, (bf16_t*)(ws + WS_WGLU), 2, 0, scr, it - 512, lane); return; }
    if (it < 3072) { transpose_item(P.in[24], D, 3 * D, P.in[6] + D, (bf16_t*)(ws + WS_WQKV), 0, 0, scr, it - 1536, lane); return; }
    transpose_item(P.in[25], D, D, nullptr, (bf16_t*)(ws + WS_WO), 0, 0, scr, it - 3072, lane);
}
constexpr int N_WITEMS = 12 * 1408 + 1280 + 3584;

__device__ __forceinline__ void s5_setup_group(const Params& P, int g, LAS float* lds) {
    LAS float* PW = lds;
    LAS float* BB = PW + 17 * 128;
    LAS float* CC = BB + 2048;
    LAS float* KT = CC + 2048;
    const int tid = otid();
    bf16_t* Bst = (bf16_t*)(P.ws + WS_BST) + (size_t)g * 256 * 256;
    bf16_t* Bcat = (bf16_t*)(P.ws + WS_BCAT) + (size_t)g * 256 * A5K;
    float* ab16 = (float*)(P.ws + WS_AB16);
    if (tid < 64) {
        const int p = tid;
        double lre = (double)P.in[15][g * 64 + p]; if (lre > -1e-4) lre = -1e-4;
        const double lim = (double)P.in[16][g * 64 + p];
        const double dt = exp((double)P.in[17][g]);
        const double mag = exp(lre * dt);
        double x = lim * dt; const double twopi = 6.283185307179586476925; x -= twopi * rint(x / twopi);
        const double y = x * (1.0 / 16.0), y2 = y * y;
        double sn = y * (1.0 - y2 / 6.0 * (1.0 - y2 / 20.0 * (1.0 - y2 / 42.0 * (1.0 - y2 / 72.0 * (1.0 - y2 / 110.0 * (1.0 - y2 / 156.0))))));
        double cs = 1.0 - y2 / 2.0 * (1.0 - y2 / 12.0 * (1.0 - y2 / 30.0 * (1.0 - y2 / 56.0 * (1.0 - y2 / 90.0 * (1.0 - y2 / 132.0 * (1.0 - y2 / 182.0))))));
#pragma unroll
        for (int k = 0; k < 4; ++k) { const double s2 = 2.0 * sn * cs, c2 = cs * cs - sn * sn; sn = s2; cs = c2; }
        const double ar = mag * cs, ai = mag * sn;
        const double nr = ar - 1.0, ni = ai, den = lre * lre + lim * lim;
        const double fr = (nr * lre + ni * lim) / den, fi = (ni * lre - nr * lim) / den;
        double pr = 1.0, pi = 0.0;
        for (int tau = 0; tau <= 16; ++tau) { PW[(tau * 64 + p) * 2] = (float)pr; PW[(tau * 64 + p) * 2 + 1] = (float)pi; const double npr = pr * ar - pi * ai, npi = pr * ai + pi * ar; pr = npr; pi = npi; }
        ab16[(g * 64 + p) * 2] = PW[(16 * 64 + p) * 2]; ab16[(g * 64 + p) * 2 + 1] = PW[(16 * 64 + p) * 2 + 1];
        for (int hi = 0; hi < 16; ++hi) { const double br = (double)P.in[18][(size_t)(g * 64 + p) * 16 + hi], bi = (double)P.in[19][(size_t)(g * 64 + p) * 16 + hi];
            BB[(p * 16 + hi) * 2] = (float)(fr * br - fi * bi); BB[(p * 16 + hi) * 2 + 1] = (float)(fr * bi + fi * br); }
    }
    for (int i = tid; i < 1024; i += NTHREADS) { CC[i * 2] = P.in[20][(size_t)g * 1024 + i]; CC[i * 2 + 1] = P.in[21][(size_t)g * 1024 + i]; }
    __syncthreads();
    for (int i = tid; i < 4096; i += NTHREADS) { const int tau = i >> 8, ho = (i >> 4) & 15, hi = i & 15; float a = 0.f;
        for (int p = 0; p < 64; ++p) { const float cr = CC[(ho * 64 + p) * 2], ci = CC[(ho * 64 + p) * 2 + 1], pr = PW[(tau * 64 + p) * 2], pi = PW[(tau * 64 + p) * 2 + 1];
            const float wr = cr * pr - ci * pi, wi = cr * pi + ci * pr; a += wr * BB[(p * 16 + hi) * 2] - wi * BB[(p * 16 + hi) * 2 + 1]; }
        KT[i] = a; }
    __syncthreads();
    for (int idx = tid; idx < 256 * 32; idx += NTHREADS) { const int n = idx >> 5, k0 = (idx & 31) * 8, j = k0 >> 4, hi0 = k0 & 15; float v[8];
        if (n < 128) { const int p = n >> 1, ri = n & 1; const float pr = PW[((15 - j) * 64 + p) * 2], pi = PW[((15 - j) * 64 + p) * 2 + 1];
#pragma unroll
            for (int e = 0; e < 8; ++e) { const float br = BB[(p * 16 + hi0 + e) * 2], bi = BB[(p * 16 + hi0 + e) * 2 + 1]; v[e] = ri ? (pr * bi + pi * br) : (pr * br - pi * bi); } }
        else {
#pragma unroll
            for (int e = 0; e < 8; ++e) v[e] = 0.f; }
        u32x4 o; o.x = cvt_pk_bf16(v[0], v[1]); o.y = cvt_pk_bf16(v[2], v[3]); o.z = cvt_pk_bf16(v[4], v[5]); o.w = cvt_pk_bf16(v[6], v[7]);
        *(u32x4*)(Bst + (size_t)n * 256 + k0) = o; }
    for (int idx = tid; idx < 256 * 48; idx += NTHREADS) { const int n = idx / 48, k0 = (idx % 48) * 8, tl = n >> 4, ho = n & 15; float v[8];
        if (k0 < 256) { const int j = k0 >> 4, hi0 = k0 & 15;
#pragma unroll
            for (int e = 0; e < 8; ++e) v[e] = (tl >= j) ? KT[((tl - j) * 16 + ho) * 16 + hi0 + e] : 0.f; }
        else { const int kk0 = k0 - 256;
#pragma unroll
            for (int e = 0; e < 8; ++e) { const int kk = kk0 + e, p = kk >> 1, ri = kk & 1; const float cr = CC[(ho * 64 + p) * 2], ci = CC[(ho * 64 + p) * 2 + 1], pr = PW[((tl + 1) * 64 + p) * 2], pi = PW[((tl + 1) * 64 + p) * 2 + 1];
                v[e] = ri ? -(cr * pi + ci * pr) : (cr * pr - ci * pi); } }
        u32x4 o; o.x = cvt_pk_bf16(v[0], v[1]); o.y = cvt_pk_bf16(v[2], v[3]); o.z = cvt_pk_bf16(v[4], v[5]); o.w = cvt_pk_bf16(v[6], v[7]);
        *(u32x4*)(Bcat + (size_t)n * A5K + k0) = o; }
    __syncthreads();
}

__device__ __forceinline__ void prologue(const Params& P, LAS unsigned char* lds) {
    const int tid = otid(), lane = tid & 63, wave = tid >> 6, G = gridDim.x;
    if ((int)blockIdx.x < NG) s5_setup_group(P, blockIdx.x, (LAS float*)lds);
    const int gw = blockIdx.x * NWAVES + wave, NGW = G * NWAVES;
    LAS float* scr = (LAS float*)(lds + wave * 16384);
    for (int it = gw; it < N_WITEMS; it += NGW) weight_item(P, it, scr, lane);
    const float* x = P.in[0]; bf16_t* hb = (bf16_t*)(P.ws + WS_HB); float* ssq = (float*)(P.ws + WS_SSQ);
    for (int m = gw; m < T; m += NGW) {
        const f32x4* xr = (const f32x4*)(x + (size_t)m * D) + lane; f32x4 v[4]; float s = 0.f;
#pragma unroll
        for (int j = 0; j < 4; ++j) { v[j] = xr[64 * j]; s += (v[j][0] * v[j][0] + v[j][1] * v[j][1]) + (v[j][2] * v[j][2] + v[j][3] * v[j][3]); }
        s = wave_sum(s);
        u32x2* o = (u32x2*)(hb + (size_t)m * D) + lane;
#pragma unroll
        for (int j = 0; j < 4; ++j) { u32x2 w; w.x = cvt_pk_bf16(v[j][0], v[j][1]); w.y = cvt_pk_bf16(v[j][2], v[j][3]); o[64 * j] = w; }
        if (lane < 16) ssq[(size_t)m * 16 + lane] = (lane == 0) ? s : 0.f;
    }
    const f32x4* pp = (const f32x4*)P.in[1]; u32x2* pb = (u32x2*)(P.ws + WS_PB);
    const size_t n4 = (size_t)2 * T * PD / 4;
    for (size_t i = (size_t)blockIdx.x * NTHREADS + tid; i < n4; i += (size_t)G * NTHREADS) { const f32x4 v = pp[i]; u32x2 w; w.x = cvt_pk_bf16(v[0], v[1]); w.y = cvt_pk_bf16(v[2], v[3]); pb[i] = w; }
}

__device__ __forceinline__ void s5_scan(const Params& P) {
    const int tid = otid(), lane = tid & 63, wave = tid >> 6;
    const float* Sloc = (const float*)(P.ws + WS_BIG + 96 * MiB); bf16_t* A5 = (bf16_t*)(P.ws + WS_BIG); const float* ab16 = (const float*)(P.ws + WS_AB16);
    for (int pair = blockIdx.x + gridDim.x * wave; pair < NB * NG; pair += gridDim.x * NWAVES) {
        const int b = pair / NG, g = pair % NG, p = lane;
        const float ar = ab16[(g * 64 + p) * 2], ai = ab16[(g * 64 + p) * 2 + 1];
        float sr = 0.f, si = 0.f;
        const f32x2* src = (const f32x2*)(Sloc + ((size_t)g * CROWS + b * NCH) * 128) + p;
        unsigned* dst = (unsigned*)(A5 + ((size_t)g * CROWS + b * NCH) * A5K + 256) + p;
        for (int c0 = 0; c0 < NCH; c0 += 8) {
            f32x2 v[8];
#pragma unroll
            for (int j = 0; j < 8; ++j) v[j] = src[(size_t)(c0 + j) * 64];
#pragma unroll
            for (int j = 0; j < 8; ++j) { dst[(size_t)(c0 + j) * (A5K / 2)] = cvt_pk_bf16(sr, si);
                const float nr = ar * sr - ai * si + v[j][0], ni = ar * si + ai * sr + v[j][1]; sr = nr; si = ni; }
        }
    }
}

__device__ __forceinline__ float shfl32(float v) { return __shfl_xor(v, 32); }
__device__ __forceinline__ void attn_phase(const Params& P) {
    const int tid = otid(), lane = tid & 63, wave = tid >> 6, r32 = lane & 31, hi = lane >> 5;
    const bf16_t* Q = (const bf16_t*)(P.ws + WS_BIG); const bf16_t* Kk = (const bf16_t*)(P.ws + WS_BIG + 64 * MiB); const bf16_t* Vt = (const bf16_t*)(P.ws + WS_EXTRA);
    bf16_t* O = (bf16_t*)(P.ws + WS_BIG);
    const int NGW = gridDim.x * NWAVES;
    for (int unit = blockIdx.x + gridDim.x * wave; unit < NB * 16 * 64; unit += NGW) {
        const int bh = unit >> 6, qb = unit & 63, b = bh >> 4, h = bh & 15, q0 = qb * 32; const size_t tokbase = (size_t)b * SEQ;
        bf16x8 qf[4];
#pragma unroll
        for (int d0 = 0; d0 < 4; ++d0) qf[d0] = *(const bf16x8*)(Q + (tokbase + q0 + r32) * D + h * 64 + d0 * 16 + hi * 8);
        f32x16 o0 = {}, o1 = {}; float carry = 1.0f;
        for (int kt = qb; kt >= 0; --kt) {
            const int kv0 = kt * 32;
            bf16x8 kf[4];
#pragma unroll
            for (int d0 = 0; d0 < 4; ++d0) kf[d0] = *(const bf16x8*)(Kk + (tokbase + kv0 + r32) * D + h * 64 + d0 * 16 + hi * 8);
            u32x2 vlo[2][2], vhi[2][2];
#pragma unroll
            for (int db = 0; db < 2; ++db)
#pragma unroll
                for (int kk = 0; kk < 2; ++kk) { const bf16_t* vp = Vt + (size_t)(h * 64 + db * 32 + r32) * T + tokbase + kv0 + 16 * kk + 4 * hi;
                    vlo[db][kk] = *(const u32x2*)vp; vhi[db][kk] = *(const u32x2*)(vp + 8); }
            f32x16 s = {};
#pragma unroll
            for (int d0 = 0; d0 < 4; ++d0) s = __builtin_amdgcn_mfma_f32_32x32x16_bf16(kf[d0], qf[d0], s, 0, 0, 0);
            float kp[16], sg[16];
#pragma unroll
            for (int r = 0; r < 16; ++r) { const float t = __builtin_amdgcn_exp2f(fminf(s[r], 80.0f)); const float rr = fast_rcp(1.0f + t); kp[r] = rr; sg[r] = t * rr; }
            if (kt == qb) {
#pragma unroll
                for (int r = 0; r < 16; ++r) { const int i = (r & 3) + 8 * (r >> 2) + 4 * hi; if (i >= r32) { kp[r] = 1.0f; sg[r] = 0.f; } }
            }
            float ex[16], tot[4];
#pragma unroll
            for (int bq = 0; bq < 4; ++bq) { ex[4 * bq + 3] = 1.0f; ex[4 * bq + 2] = kp[4 * bq + 3]; ex[4 * bq + 1] = ex[4 * bq + 2] * kp[4 * bq + 2]; ex[4 * bq] = ex[4 * bq + 1] * kp[4 * bq + 1]; tot[bq] = ex[4 * bq] * kp[4 * bq]; }
            float pt[4], Y[4];
#pragma unroll
            for (int bq = 0; bq < 4; ++bq) pt[bq] = shfl32(tot[bq]);
            Y[3] = carry; Y[2] = Y[3] * (tot[3] * pt[3]); Y[1] = Y[2] * (tot[2] * pt[2]); Y[0] = Y[1] * (tot[1] * pt[1]); carry = Y[0] * (tot[0] * pt[0]);
            float att[16];
#pragma unroll
            for (int bq = 0; bq < 4; ++bq) { const float X = hi ? Y[bq] : Y[bq] * pt[bq];
#pragma unroll
                for (int w = 0; w < 4; ++w) att[4 * bq + w] = sg[4 * bq + w] * (X * ex[4 * bq + w]); }
            bf16x8 pb[2];
#pragma unroll
            for (int kk = 0; kk < 2; ++kk) { u32x4 w; w.x = cvt_pk_bf16(att[8 * kk], att[8 * kk + 1]); w.y = cvt_pk_bf16(att[8 * kk + 2], att[8 * kk + 3]); w.z = cvt_pk_bf16(att[8 * kk + 4], att[8 * kk + 5]); w.w = cvt_pk_bf16(att[8 * kk + 6], att[8 * kk + 7]);
                pb[kk] = __builtin_bit_cast(bf16x8, w); }
#pragma unroll
            for (int kk = 0; kk < 2; ++kk) {
                u32x4 a0; a0.x = vlo[0][kk].x; a0.y = vlo[0][kk].y; a0.z = vhi[0][kk].x; a0.w = vhi[0][kk].y;
                u32x4 a1; a1.x = vlo[1][kk].x; a1.y = vlo[1][kk].y; a1.z = vhi[1][kk].x; a1.w = vhi[1][kk].y;
                o0 = __builtin_amdgcn_mfma_f32_32x32x16_bf16(__builtin_bit_cast(bf16x8, a0), pb[kk], o0, 0, 0, 0);
                o1 = __builtin_amdgcn_mfma_f32_32x32x16_bf16(__builtin_bit_cast(bf16x8, a1), pb[kk], o1, 0, 0, 0);
            }
            if (!__any(carry > 1e-30f)) break;
        }
        bf16_t* op = O + (tokbase + q0 + r32) * D + h * 64 + 4 * hi;
#pragma unroll
        for (int rq = 0; rq < 4; ++rq) {
            u32x2 w0; w0.x = cvt_pk_bf16(o0[4 * rq], o0[4 * rq + 1]); w0.y = cvt_pk_bf16(o0[4 * rq + 2], o0[4 * rq + 3]); *(u32x2*)(op + 8 * rq) = w0;
            u32x2 w1; w1.x = cvt_pk_bf16(o1[4 * rq], o1[4 * rq + 1]); w1.y = cvt_pk_bf16(o1[4 * rq + 2], o1[4 * rq + 3]); *(u32x2*)(op + 32 + 8 * rq) = w1;
        }
    }
}

__device__ __forceinline__ void final_norm(const Params& P, const float* ssq) {
    const int tid = otid(), lane = tid & 63, wave = tid >> 6; const int gw = blockIdx.x * NWAVES + wave, NGW = gridDim.x * NWAVES;
    const f32x4* gp = (const f32x4*)P.in[26] + lane; f32x4 gv[4];
#pragma unroll
    for (int j = 0; j < 4; ++j) gv[j] = gp[64 * j];
    for (int m = gw; m < T; m += NGW) {
        float s = (lane < 16) ? ssq[(size_t)m * 16 + lane] : 0.f; s = wave_sum(s);
        const float rs = rsqrtf(s * (1.0f / D) + EPS);
        f32x4* hr = (f32x4*)(P.out + (size_t)m * D) + lane;
#pragma unroll
        for (int j = 0; j < 4; ++j) { f32x4 v = hr[64 * j]; hr[64 * j] = v * rs * gv[j]; }
    }
}

constexpr int N_PHASES = 22;
__global__ void __launch_bounds__(NTHREADS, 2) mk_fwd(Params P) {
    extern __shared__ __attribute__((aligned(16))) unsigned char lds_raw[];
    LAS unsigned char* lds = (LAS unsigned char*)lds_raw;
    cg::grid_group grid = cg::this_grid();
    const int lo = P.ph_lo, hi = P.ph_hi, G = gridDim.x, c = blockIdx.x;
    unsigned char* ws = P.ws;
    bf16_t* hb = (bf16_t*)(ws + WS_HB); float* hf = P.out;
    bf16_t* hid = (bf16_t*)(ws + WS_BIG);
#define SSQB(i) ((float*)(ws + WS_SSQ + (size_t)(i) * 4 * MiB))
    int ph = 0, sq = 0;
    int np_cur = 16;
#define RUN(k) ((k) >= lo && (k) < hi)
#define SEAM() do { if (RUN(ph) && RUN(ph + 1)) grid.sync(); ++ph; } while (0)
    (void)np_cur;
    if (RUN(ph)) prologue(P, lds);
    SEAM();
    const float* hin = P.in[0];
#pragma unroll 1
    for (int li = 0; li < 2; ++li) {
#pragma unroll 1
        for (int w = 0; w < 2; ++w) {
            if (RUN(ph)) {
                pg8::Gemm g{hb, (const bf16_t*)(ws + WS_WUP + (size_t)(li * 2 + w) * SZ_WUP), D, D, D, 0, 0};
                pg8::Order S; S.init(T, 2 * FF, 1, G, c);
                if (li == 0 && w == 1) { pg8::EpiUp<32> E{hid, SSQB(sq)}; pg8::gemm_phase(lds, g, S, E); }
                else { pg8::EpiUp<16> E{hid, SSQB(sq)}; pg8::gemm_phase(lds, g, S, E); }
            }
            SEAM();
            if (RUN(ph)) {
                pg8::Gemm g{hid, (const bf16_t*)(ws + WS_WDN + (size_t)(li * 2 + w) * SZ_WDN), FF, FF, FF, 0, 0};
                pg8::Order S; S.init(T, D, 1, G, c);
                pg8::EpiRes E{hin, hf, hb, SSQB(sq ^ 1), 0.5f}; pg8::gemm_phase(lds, g, S, E);
            }
            hin = hf; sq ^= 1;
            SEAM();
            if (w == 0) {
                if (li == 0) {
                    if (RUN(ph)) {
                        pg8::Gemm g{hb, (const bf16_t*)(ws + WS_WIN), D, D, D, 0, 0}; pg8::Order S; S.init(T, D, 1, G, c);
                        pg8::EpiWin<16> E{(bf16_t*)(ws + WS_BIG), SSQB(sq)}; pg8::gemm_phase(lds, g, S, E);
                    }
                    SEAM();
                    if (RUN(ph)) {
                        pg8::Gemm g{(const bf16_t*)(ws + WS_BIG), (const bf16_t*)(ws + WS_BST), A5K, 256, 256, (size_t)CROWS * A5K * 2, (size_t)256 * 256 * 2};
                        pg8::Order S; S.init(CROWS, 256, NG, G, c);
                        pg8::EpiSloc E{(float*)(ws + WS_BIG + 96 * MiB)}; pg8::gemm_phase(lds, g, S, E);
                    }
                    SEAM();
                    if (RUN(ph)) s5_scan(P);
                    SEAM();
                    if (RUN(ph)) {
                        pg8::Gemm g{(const bf16_t*)(ws + WS_BIG), (const bf16_t*)(ws + WS_BCAT), A5K, A5K, A5K, (size_t)CROWS * A5K * 2, (size_t)256 * A5K * 2};
                        pg8::Order S; S.init(CROWS, 256, NG, G, c);
                        pg8::EpiY E{(const bf16_t*)(ws + WS_BIG), P.in[22], (bf16_t*)(ws + WS_EXTRA)}; pg8::gemm_phase(lds, g, S, E);
                    }
                    SEAM();
                    if (RUN(ph)) {
                        pg8::Gemm g{(const bf16_t*)(ws + WS_EXTRA), (const bf16_t*)(ws + WS_WGLU), D, D, D, 0, 0}; pg8::Order S; S.init(T, 2 * D, 1, G, c);
                        pg8::EpiGlu E{hf, hf, hb, SSQB(sq ^ 1)}; pg8::gemm_phase(lds, g, S, E);
                    }
                    sq ^= 1;
                    SEAM();
                } else {
                    if (RUN(ph)) {
                        { pg8::Gemm g{hb, (const bf16_t*)(ws + WS_WQKV), D, D, D, 0, 0}; pg8::Order S; S.init(T, 2 * D, 1, G, c);
                          pg8::EpiQK<16> E{(bf16_t*)(ws + WS_BIG), (bf16_t*)(ws + WS_BIG + 64 * MiB), SSQB(sq)}; pg8::gemm_phase(lds, g, S, E); }
                        { pg8::Gemm g{(const bf16_t*)(ws + WS_WQKV) + (size_t)2 * D * D, hb, D, D, D, 0, 0}; pg8::Order S; S.init(D, T, 1, G, c);
                          pg8::EpiVt<16> E{(bf16_t*)(ws + WS_EXTRA), SSQB(sq)}; pg8::gemm_phase(lds, g, S, E); }
                    }
                    SEAM();
                    if (RUN(ph)) attn_phase(P);
                    SEAM();
                    if (RUN(ph)) {
                        pg8::Gemm g{(const bf16_t*)(ws + WS_BIG), (const bf16_t*)(ws + WS_WO), D, D, D, 0, 0}; pg8::Order S; S.init(T, D, 1, G, c);
                        pg8::EpiRes E{hf, hf, hb, SSQB(sq ^ 1), 1.0f}; pg8::gemm_phase(lds, g, S, E);
                    }
                    sq ^= 1;
                    SEAM();
                }
            }
        }
        if (RUN(ph)) {
            pg8::Gemm g{(const bf16_t*)(ws + WS_PB) + (size_t)li * T * PD, (const bf16_t*)(ws + WS_WP + (size_t)li * (MiB / 2)), PD, PD, PD, 0, 0}; pg8::Order S; S.init(T, D, 1, G, c);
            pg8::EpiPlain E{(bf16_t*)(ws + WS_EXTRA), D}; pg8::gemm_phase(lds, g, S, E);
        }
        SEAM();
        if (RUN(ph)) {
            pg8::Gemm g{hb, (const bf16_t*)(ws + WS_WG + (size_t)li * 2 * MiB), D, D, D, 0, 0}; pg8::Order S; S.init(T, D, 1, G, c);
            pg8::EpiPle<16> E{hf, hf, hb, (const bf16_t*)(ws + WS_EXTRA), SSQB(sq), SSQB(sq ^ 1)}; pg8::gemm_phase(lds, g, S, E);
        }
        sq ^= 1;
        SEAM();
    }
    if (RUN(ph)) final_norm(P, SSQB(sq));
#undef RUN
#undef SEAM
}

extern "C" void kernel_launch(void* const* d_in, const int* in_sizes, int n_in, void* d_out, int out_size, void* d_ws, size_t ws_size, hipStream_t stream) {
    static int grid = 0;
    if (grid == 0) {
        if (n_in != 27 || out_size != T * D || ws_size < WS_END) { fprintf(stderr, "kernel_launch: unexpected problem (n_in %d out %d ws %zu)\n", n_in, out_size, ws_size); grid = -1; return; }
        int dev = 0, cus = 0, per_cu = 0;
        hipGetDevice(&dev); hipDeviceGetAttribute(&cus, hipDeviceAttributeMultiprocessorCount, dev);
        hipFuncSetAttribute((const void*)mk_fwd, hipFuncAttributeMaxDynamicSharedMemorySize, LDS_BYTES);
        hipOccupancyMaxActiveBlocksPerMultiprocessor(&per_cu, (const void*)mk_fwd, NTHREADS, LDS_BYTES);
        if (per_cu < 1) per_cu = 1;
        grid = cus * per_cu;
        if (grid > 256) grid = 256;
        (void)hipGetLastError();
    }
    if (grid < 0) return;
    Params p{};
    for (int i = 0; i < 27; ++i) p.in[i] = (const float*)d_in[i];
    p.out = (float*)d_out; p.ws = (unsigned char*)d_ws;
#if MK_MULTI
    for (int k = 0; k < N_PHASES; ++k) { p.ph_lo = k; p.ph_hi = k + 1; void* args[] = {&p};
        (void)args; hipLaunchKernelGGL(mk_fwd, dim3(grid), dim3(NTHREADS), LDS_BYTES, stream, p);
        hipError_t e = hipPeekAtLastError();
        if (e != hipSuccess) { fprintf(stderr, "launch %d failed: %s\n", k, hipGetErrorString(e)); break; } }
#else
    p.ph_lo = 0; p.ph_hi = N_PHASES; void* args[] = {&p};
    hipError_t e = hipLaunchCooperativeKernel((const void*)mk_fwd, dim3(grid), dim3(NTHREADS), args, LDS_BYTES, stream);
    if (e != hipSuccess) fprintf(stderr, "cooperative launch failed: %s (grid %d)\n", hipGetErrorString(e), grid);
#endif
}
```

```cpp
#include <hip/hip_runtime.h>
#include <hip/hip_cooperative_groups.h>
#include <cstdio>
#include <cstdint>
namespace cg = cooperative_groups;

#ifndef MK_MULTI
#define MK_MULTI 0
#endif

#define LAS __attribute__((address_space(3)))
typedef unsigned short bf16_t;
typedef short bf16x8 __attribute__((ext_vector_type(8)));
typedef float f32x4 __attribute__((ext_vector_type(4)));
typedef float f32x2 __attribute__((ext_vector_type(2)));
typedef float f32x16 __attribute__((ext_vector_type(16)));
typedef unsigned u32x4 __attribute__((ext_vector_type(4)));
typedef unsigned u32x2 __attribute__((ext_vector_type(2)));

constexpr int NB = 16, SEQ = 2048, T = NB * SEQ, D = 1024, FF = 2816, PD = 256;
constexpr int NG = 64, NCH = 128, CROWS = NB * NCH, A5K = 384;
constexpr float EPS = 1e-6f;
constexpr float QSCALE = 0.125f * 1.4426950408889634f;
constexpr int NTHREADS = 512, NWAVES = 8;

constexpr size_t MiB = 1u << 20;
constexpr size_t WS_WUP = 1 * MiB;
constexpr size_t SZ_WUP = 11 * MiB;
constexpr size_t WS_WDN = WS_WUP + 4 * SZ_WUP;
constexpr size_t SZ_WDN = 11 * MiB / 2;
constexpr size_t WS_WG = WS_WDN + 4 * SZ_WDN;
constexpr size_t WS_WP = WS_WG + 4 * MiB;
constexpr size_t WS_WIN = WS_WP + 1 * MiB;
constexpr size_t WS_WGLU = WS_WIN + 2 * MiB;
constexpr size_t WS_WQKV = WS_WGLU + 4 * MiB;
constexpr size_t WS_WO = WS_WQKV + 6 * MiB;
constexpr size_t WS_BST = WS_WO + 2 * MiB;
constexpr size_t WS_BCAT = WS_BST + 4 * MiB;
constexpr size_t WS_AB16 = WS_BCAT + 12 * MiB;
constexpr size_t WS_SSQ = 103 * MiB;
constexpr size_t WS_HB = 107 * MiB;
constexpr size_t WS_PB = 171 * MiB;
constexpr size_t WS_BIG = 203 * MiB;
constexpr size_t WS_EXTRA = 379 * MiB;
constexpr size_t WS_HB2 = 443 * MiB;
constexpr size_t WS_END = 507 * MiB;
constexpr size_t SLICE = 22 * MiB, SLOC_OFF = 12 * MiB, VT_SLICE = 8 * MiB;

constexpr int LDS_BYTES = 131072 + 1024 + 16384;

__device__ __forceinline__ unsigned cvt_pk_bf16(float lo, float hi) { unsigned r; asm volatile("v_cvt_pk_bf16_f32 %0, %1, %2" : "=v"(r) : "v"(lo), "v"(hi)); return r; }
__device__ __forceinline__ float bf_lo(unsigned w) { return __uint_as_float(w << 16); }
__device__ __forceinline__ float bf_hi(unsigned w) { return __uint_as_float(w & 0xffff0000u); }
__device__ __forceinline__ float fast_rcp(float x) { return __builtin_amdgcn_rcpf(x); }
__device__ __forceinline__ float sigmoidf_(float x) { return fast_rcp(1.0f + __expf(-x)); }
__device__ __forceinline__ int olane() { int l; asm volatile("v_mbcnt_lo_u32_b32 %0, -1, 0\n\tv_mbcnt_hi_u32_b32 %0, -1, %0" : "=v"(l)); return l; }
__device__ __forceinline__ int otid(int wv) { return wv * 64 + olane(); }
template <int M> __device__ __forceinline__ float swz_xor(float v) { return __builtin_bit_cast(float, __builtin_amdgcn_ds_swizzle(__builtin_bit_cast(int, v), (M << 10) | 0x1F)); }
__device__ __forceinline__ float half_sum(float v) { auto rr = __builtin_amdgcn_permlane32_swap(__float_as_uint(v), __float_as_uint(v), false, false); return __uint_as_float(rr[0]) + __uint_as_float(rr[1]); }
__device__ __forceinline__ float wave_sum(float v) { v += swz_xor<1>(v); v += swz_xor<2>(v); v += swz_xor<4>(v); v += swz_xor<8>(v); v += swz_xor<16>(v); return half_sum(v); }

namespace pg8 {
constexpr int BM = 256, BK = 64, HALF = 128, HTB = HALF * BK * 2, STAGE_BYTES = 8 * HTB, NXCD = 8, WGM = 8;
__host__ __device__ __forceinline__ int lds_byte(int r, int c) { const int st = (r >> 4) * 2 + (c >> 5), rr = r & 15, cc = c & 31, ob = rr * 64 + cc * 2; return st * 1024 + (ob ^ (((ob >> 9) & 1) << 5)); }
__host__ __device__ __forceinline__ void stage_rc(int b, int& R, int& C) { const int st = b / 1024, sb = b % 1024, swz = sb ^ (((sb >> 9) & 1) << 5); R = (st >> 1) * 16 + swz / 64; C = (st & 1) * 32 + (swz % 64) / 2; }
__host__ __device__ __forceinline__ int perm32(int rho) { const int n = rho >> 4, i = rho & 15; return 8 * (i >> 2) + 4 * n + (i & 3); }

struct Unit { int pm, pn, grp; };
struct Gemm { const bf16_t* A; const bf16_t* Bt; int lda, ldb, K; size_t gsA, gsB, psA; };

struct Order {
    int nM, nN, nwg, G, c, ngrp, panel_pm, panel_pn0, panel_n;
    __device__ __forceinline__ void init(int M, int N, int ngrp_, int G_, int c_) { nM = M / BM; nN = N / BM; nwg = nM * nN; G = G_; c = c_; ngrp = ngrp_; panel_n = 0; panel_pm = 0; panel_pn0 = 0; quad_n = 0; quad_pm0 = 0; quad_r = 0; }
    __device__ __forceinline__ bool init_panel() { if (G % nM != 0 || G % NXCD != 0) return false; const int wpp = G / nM, per = (nN + wpp - 1) / wpp, v = (c % NXCD) * (G / NXCD) + c / NXCD;
        panel_pm = v / wpp; panel_pn0 = (v % wpp) * per; panel_n = (panel_pn0 + per <= nN) ? per : (nN - panel_pn0 > 0 ? nN - panel_pn0 : 0); if (panel_n == 0) panel_n = -1; return true; }
    int quad_n, quad_pm0, quad_r;
    __device__ __forceinline__ bool init_quad() { quad_n = 0; if (G != 2 * nM || (2 * nN) % 4 != 0 || G % NXCD != 0) return false; const int v = (c % NXCD) * (G / NXCD) + c / NXCD;
        quad_pm0 = 2 * (v >> 2); quad_r = v & 3; quad_n = (2 * nN) / 4; panel_n = 0; return true; }
    __device__ __forceinline__ bool next(int i, Unit& u) const {
        if (quad_n != 0) { if (i >= quad_n) return false; const int f = 4 * i + quad_r; u.grp = 0; u.pm = quad_pm0 + (f >= nN ? 1 : 0); u.pn = f >= nN ? f - nN : f; return true; }
        if (panel_n != 0) { if (i >= panel_n) return false; u.grp = 0; u.pm = panel_pm; u.pn = panel_pn0 + i; return true; }
        const long L = (long)i * G + c; if (L >= (long)nwg * ngrp) return false;
        if (ngrp > 1) { u.grp = (int)(L / nwg); const int r = (int)(L % nwg); u.pm = r / nN; u.pn = r % nN; return true; }
        u.grp = 0;
        int wgid = (int)L; { const int q = nwg / NXCD, r = nwg % NXCD, xcd = wgid % NXCD, off = wgid / NXCD; wgid = (xcd < r ? xcd * (q + 1) : r * (q + 1) + (xcd - r) * q) + off; }
        const int nig = WGM * nN, gid = wgid / nig, fm = gid * WGM, gsz = (nM - fm) < WGM ? (nM - fm) : WGM;
        u.pm = fm + ((wgid % nig) % gsz); u.pn = (wgid % nig) / gsz; return true;
    }
};

template <class Epi>
__device__ __forceinline__ void gemm_phase(LAS unsigned char* lds, const Gemm g, const Order& S, const Epi& E, int wv, unsigned* dump) {
    const int lane = olane(), wid = wv, tid = wid * 64 + lane, wr = wid >> 2, wc = wid & 3, fr = lane & 15, fq = lane >> 4;
    int nt_ = g.K / BK; asm volatile("" : "+s"(nt_)); const int nt = nt_;
    unsigned voffA, voffB;
    { int R, C; stage_rc(tid * 16, R, C); const int Rb = (R & ~31) + perm32(R & 31);
      voffA = (unsigned)(R * g.lda + C) * 2u; voffB = (unsigned)(Rb * g.ldb + C) * 2u; }
    const size_t pstepA = (size_t)64 * g.lda * 2, pstepB = (size_t)64 * g.ldb * 2;
    const size_t kstep = (size_t)(BK * 2);
    const size_t hstepA = (size_t)HALF * g.lda * 2, hstepB = (size_t)HALF * g.ldb * 2;
    const size_t tstepA = g.psA ? g.psA : 2 * hstepA, tstepB = 2 * hstepB;
    const unsigned ldsw = (unsigned)wid * 1024u;
    const int aoff = lds_byte(wr * 64 + fr, fq * 8), boff = lds_byte(wc * 32 + fr, fq * 8);
#define PG8_SA(b, h) (((b) * 2 + (h)) * HTB)
#define PG8_SB(b, h) ((4 + (b) * 2 + (h)) * HTB)
#define PG8_STAGE(bufoff, gbase, voff) do { _Pragma("unroll") for (int _i = 0; _i < 2; ++_i) \
        __builtin_amdgcn_global_load_lds((const unsigned*)((const char*)(gbase) + (size_t)_i * pstep_##voff + (voff)), (LAS unsigned*)(lds + (bufoff) + ldsw + _i * 8192), 16, 0, 0); } while (0)
#define pstep_voffA pstepA
#define pstep_voffB pstepB
#define PG8_LDA(dst, b, h) do { _Pragma("unroll") for (int m = 0; m < 4; ++m) _Pragma("unroll") for (int k = 0; k < 2; ++k) dst[m][k] = *(const LAS bf16x8*)(lds + PG8_SA(b, h) + aoff + m * 2048 + k * 1024); } while (0)
#define PG8_LDB(dst, b, h) do { _Pragma("unroll") for (int n = 0; n < 2; ++n) _Pragma("unroll") for (int k = 0; k < 2; ++k) dst[n][k] = *(const LAS bf16x8*)(lds + PG8_SB(b, h) + boff + n * 2048 + k * 1024); } while (0)
#define PG8_MMA(ai, bj, At, Bt) do { __builtin_amdgcn_s_setprio(1); _Pragma("unroll") for (int m = 0; m < 4; ++m) _Pragma("unroll") for (int n = 0; n < 2; ++n) _Pragma("unroll") for (int k = 0; k < 2; ++k) \
        acc[ai][bj][m][n] = __builtin_amdgcn_mfma_f32_16x16x32_bf16(Bt[n][k], At[m][k], acc[ai][bj][m][n], 0, 0, 0); __builtin_amdgcn_s_setprio(0); } while (0)
#define PG8_WAIT_V(n) asm volatile("s_waitcnt vmcnt(" #n ")" ::: "memory")
#define PG8_WAIT_L(n) asm volatile("s_waitcnt lgkmcnt(" #n ")" ::: "memory")
#define PG8_BAR __builtin_amdgcn_s_barrier()
#define PG8_SCHED __builtin_amdgcn_sched_barrier(0)
    Unit cur, nxt; int ui = 0;
    if (!S.next(0, cur)) return;
    f32x4 acc[2][2][4][2];
#pragma unroll
    for (int a = 0; a < 2; ++a)
#pragma unroll
        for (int b = 0; b < 2; ++b)
#pragma unroll
            for (int m = 0; m < 4; ++m)
#pragma unroll
                for (int n = 0; n < 2; ++n) acc[a][b][m][n] = (f32x4){0.f, 0.f, 0.f, 0.f};
    bf16x8 At[4][2], B0[2][2], B1[2][2];
    const char* cA = (const char*)g.A + (size_t)cur.grp * g.gsA + (size_t)cur.pm * tstepA;
    const char* cB = (const char*)g.Bt + (size_t)cur.grp * g.gsB + (size_t)cur.pn * tstepB;
    PG8_STAGE(PG8_SB(0, 0), cB, voffB); PG8_STAGE(PG8_SB(0, 1), cB + hstepB, voffB); PG8_STAGE(PG8_SA(0, 0), cA, voffA); PG8_STAGE(PG8_SA(0, 1), cA + hstepA, voffA);
    if (wr == 1) PG8_BAR;
    PG8_WAIT_V(2); PG8_BAR;
    PG8_STAGE(PG8_SB(1, 0), cB + kstep, voffB); PG8_STAGE(PG8_SA(1, 0), cA + kstep, voffA); PG8_STAGE(PG8_SB(1, 1), cB + hstepB + kstep, voffB);
    PG8_WAIT_V(6); PG8_BAR;
    for (;;) {
        const bool has_next = S.next(ui + 1, nxt);
        const char* nA = has_next ? (const char*)g.A + (size_t)nxt.grp * g.gsA + (size_t)nxt.pm * tstepA : cA;
        const char* nB = has_next ? (const char*)g.Bt + (size_t)nxt.grp * g.gsB + (size_t)nxt.pn * tstepB : cB;
#define PG8_KPAIR(WV_FIRST) do { \
            const bool last = (t == nt - 2); \
            const char* a1 = cA + (size_t)(t + 1) * kstep; \
            const char* a2 = last ? nA : cA + (size_t)(t + 2) * kstep; const char* b2 = last ? nB : cB + (size_t)(t + 2) * kstep; \
            const char* a3 = a2 + kstep; const char* b3 = b2 + kstep; \
            PG8_LDB(B0, 0, 0); PG8_LDB(B1, 0, 1); PG8_SCHED; PG8_LDA(At, 0, 0); PG8_STAGE(PG8_SA(1, 1), a1 + hstepA, voffA); \
            WV_FIRST; PG8_WAIT_L(0); PG8_BAR; PG8_MMA(0, 0, At, B0); PG8_MMA(0, 1, At, B1); PG8_BAR; PG8_SCHED; \
            PG8_LDA(At, 0, 1); PG8_STAGE(PG8_SB(0, 0), b2, voffB); PG8_STAGE(PG8_SB(0, 1), b2 + hstepB, voffB); PG8_STAGE(PG8_SA(0, 0), a2, voffA); \
            WV_FIRST; PG8_WAIT_L(0); PG8_BAR; PG8_MMA(1, 0, At, B0); PG8_MMA(1, 1, At, B1); PG8_BAR; PG8_SCHED; \
            PG8_LDB(B0, 1, 0); PG8_LDB(B1, 1, 1); PG8_SCHED; PG8_LDA(At, 1, 0); PG8_STAGE(PG8_SA(0, 1), a2 + hstepA, voffA); \
            PG8_WAIT_V(8); PG8_WAIT_L(0); PG8_BAR; PG8_MMA(0, 0, At, B0); PG8_MMA(0, 1, At, B1); PG8_BAR; PG8_SCHED; \
            PG8_LDA(At, 1, 1); PG8_STAGE(PG8_SB(1, 0), b3, voffB); PG8_STAGE(PG8_SB(1, 1), b3 + hstepB, voffB); PG8_STAGE(PG8_SA(1, 0), a3, voffA); \
            PG8_WAIT_V(8); PG8_WAIT_L(0); PG8_BAR; PG8_MMA(1, 0, At, B0); PG8_MMA(1, 1, At, B1); PG8_BAR; PG8_SCHED; } while (0)
        for (int t = 0; t < nt; t += 2) PG8_KPAIR(PG8_WAIT_V(8));
#undef PG8_KPAIR
        if constexpr (Epi::HASPRE) {
            typename Epi::Pre pre_; { const int l_ = olane(); E.pre(pre_, cur, wr, wc, l_ & 15, l_ >> 4); }
            asm volatile("" ::: "memory");
            if (wr == 0) PG8_BAR;
            { const int l_ = olane(); E(acc, cur, wr, wc, l_ & 15, l_ >> 4, pre_); }
        } else {
        if (wr == 0) PG8_BAR;
        { const int l_ = olane();
          E(acc, cur, wr, wc, l_ & 15, l_ >> 4); }
        }
        if (!has_next) break;
#pragma unroll
        for (int a = 0; a < 2; ++a)
#pragma unroll
            for (int b = 0; b < 2; ++b)
#pragma unroll
                for (int m = 0; m < 4; ++m)
#pragma unroll
                    for (int n = 0; n < 2; ++n) acc[a][b][m][n] = (f32x4){0.f, 0.f, 0.f, 0.f};
        cur = nxt; cA = nA; cB = nB; ++ui;
        if (wr == 1) PG8_BAR;
    }
    PG8_WAIT_V(0);
    PG8_BAR;
#undef PG8_SA
#undef PG8_SB
#undef PG8_STAGE
#undef pstep_voffA
#undef pstep_voffB
#undef PG8_LDA
#undef PG8_LDB
#undef PG8_MMA
#undef PG8_WAIT_V
#undef PG8_WAIT_L
#undef PG8_BAR
#undef PG8_SCHED
}

typedef f32x4 Acc[2][2][4][2];
__device__ __forceinline__ float xsum_fq(float s) {
    s += __builtin_bit_cast(float, __builtin_amdgcn_ds_swizzle(__builtin_bit_cast(int, s), 0x401F));
    auto rr = __builtin_amdgcn_permlane32_swap(__float_as_uint(s), __float_as_uint(s), false, false);
    return __uint_as_float(rr[0]) + __uint_as_float(rr[1]);
}

template <int NP> __device__ __forceinline__ void load_rstd(const float* P, int row0, int fq, float (&rs)[2][4]) {
    const float* P2 = P + (size_t)2 * MiB / 4;
#pragma unroll
    for (int ai = 0; ai < 2; ++ai)
#pragma unroll
        for (int m = 0; m < 4; ++m) {
            const f32x4* p = (const f32x4*)(P + (size_t)(row0 + 128 * ai + 16 * m) * 16) + fq;
            f32x4 v = p[0]; float s = (v[0] + v[1]) + (v[2] + v[3]);
            if (NP == 32) { const f32x4 w = *((const f32x4*)(P2 + (size_t)(row0 + 128 * ai + 16 * m) * 16) + fq); s += (w[0] + w[1]) + (w[2] + w[3]); }
            s = xsum_fq(s);
            rs[ai][m] = rsqrtf(s * (1.0f / D) + EPS);
        }
}
__device__ __forceinline__ u32x4 pack8(f32x4 a, f32x4 b) { u32x4 w; w.x = cvt_pk_bf16(a[0], a[1]); w.y = cvt_pk_bf16(a[2], a[3]); w.z = cvt_pk_bf16(b[0], b[1]); w.w = cvt_pk_bf16(b[2], b[3]); return w; }

struct RsTab { LAS float* rsl; int have, pm_base; };
template <int NP> __device__ __forceinline__ void rs_prep(RsTab& t, const float* P, int pm, int npan, int wv) { const int l = olane(); t.pm_base = pm; t.have = 1;
    for (int p = 0; p < npan; ++p) { float rs[2][4]; load_rstd<NP>(P, (pm + p) * BM + (wv >> 2) * 64 + (l & 15), l >> 4, rs);
        if ((l >> 4) == 0) { LAS f32x4* d = (LAS f32x4*)(t.rsl + ((p * 8 + wv) * 16 + (l & 15)) * 8); d[0] = (f32x4){rs[0][0], rs[0][1], rs[0][2], rs[0][3]}; d[1] = (f32x4){rs[1][0], rs[1][1], rs[1][2], rs[1][3]}; } } }
template <int NP> __device__ __forceinline__ void rs_fetch(const RsTab& t, const float* P, const Unit& u, int wr, int wc, int fr, int fq, float (&rl)[2][4]) {
    if (t.have) { const LAS f32x4* d = (const LAS f32x4*)(t.rsl + (((u.pm - t.pm_base) * 8 + wr * 4 + wc) * 16 + fr) * 8); const f32x4 a = d[0], b = d[1];
#pragma unroll
        for (int m = 0; m < 4; ++m) { rl[0][m] = a[m]; rl[1][m] = b[m]; } }
    else load_rstd<NP>(P, u.pm * BM + wr * 64 + fr, fq, rl);
}
__device__ __forceinline__ f32x2 pk_gate(f32x2 q, f32x2 g, float c) { f32x2 t = g * c; t.x = __builtin_amdgcn_exp2f(t.x); t.y = __builtin_amdgcn_exp2f(t.y); f32x2 d = t + 1.0f; d.x = __builtin_amdgcn_rcpf(d.x); d.y = __builtin_amdgcn_rcpf(d.y); return q * d; }
template <int NPIN> struct EpiUp { static constexpr bool HASPRE = false; static constexpr int NST = 8;
    bf16_t* O; const float* P; LAS float* rsl; int have, pm_base;
    __device__ __forceinline__ void prep(int pm, int npan, int wv) { const int l = olane(); pm_base = pm; have = 1;
        for (int p = 0; p < npan; ++p) { float rs[2][4]; load_rstd<NPIN>(P, (pm + p) * BM + (wv >> 2) * 64 + (l & 15), l >> 4, rs);
            if ((l >> 4) == 0) { LAS f32x4* d = (LAS f32x4*)(rsl + ((p * 8 + wv) * 16 + (l & 15)) * 8); d[0] = (f32x4){rs[0][0], rs[0][1], rs[0][2], rs[0][3]}; d[1] = (f32x4){rs[1][0], rs[1][1], rs[1][2], rs[1][3]}; } } }
    __device__ __forceinline__ void operator()(const Acc& acc, const Unit& u, int wr, int wc, int fr, int fq) const {
        const int row0 = u.pm * BM + wr * 64 + fr; float rl[2][4];
        if (have) { const LAS f32x4* d = (const LAS f32x4*)(rsl + (((u.pm - pm_base) * 8 + wr * 4 + wc) * 16 + fr) * 8); const f32x4 a = d[0], b = d[1];
#pragma unroll
            for (int m = 0; m < 4; ++m) { rl[0][m] = a[m]; rl[1][m] = b[m]; } }
        else load_rstd<NPIN>(P, row0, fq, rl);
        const int col0 = u.pn * 128 + wc * 32 + 8 * fq;
#pragma unroll
        for (int ai = 0; ai < 2; ++ai)
#pragma unroll
            for (int m = 0; m < 4; ++m) { const float r = rl[ai][m], c1 = r * -1.4426950408889634f, r2 = r * r; f32x4 o[2];
#pragma unroll
                for (int n = 0; n < 2; ++n)
#pragma unroll
                    for (int c = 0; c < 4; c += 2) { const f32x2 a = {acc[ai][0][m][n][c], acc[ai][0][m][n][c + 1]}, b = {acc[ai][1][m][n][c], acc[ai][1][m][n][c + 1]};
                        f32x2 t = a * c1; t.x = __builtin_amdgcn_exp2f(t.x); t.y = __builtin_amdgcn_exp2f(t.y);
                        f32x2 d = t + 1.0f; d.x = __builtin_amdgcn_rcpf(d.x); d.y = __builtin_amdgcn_rcpf(d.y);
                        const f32x2 v = ((a * b) * r2) * d; o[n][c] = v.x; o[n][c + 1] = v.y; }
                *(u32x4*)(O + (size_t)(row0 + ai * HALF + m * 16) * FF + col0) = pack8(o[0], o[1]); }
    }
};
__device__ __forceinline__ void unpack8(u32x4 w, f32x4& a, f32x4& b) { a[0] = bf_lo(w.x); a[1] = bf_hi(w.x); a[2] = bf_lo(w.y); a[3] = bf_hi(w.y); b[0] = bf_lo(w.z); b[1] = bf_hi(w.z); b[2] = bf_lo(w.w); b[3] = bf_hi(w.w); }
__device__ __forceinline__ float sumsq8(f32x4 h0, f32x4 h1) { return (h0[0] * h0[0] + h0[1] * h0[1]) + (h0[2] * h0[2] + h0[3] * h0[3]) + (h1[0] * h1[0] + h1[1] * h1[1]) + (h1[2] * h1[2] + h1[3] * h1[3]); }
struct EpiRes { static constexpr int NST = 24;
    static constexpr bool HASPRE = true;
    struct Pre { u32x4 hw[2][4][2]; };
    bf16_t* hb; float* Pout; float scale;
    __device__ __forceinline__ void pre(Pre& p, const Unit& u, int wr, int wc, int fr, int fq) const {
        const bf16_t* base = hb + (size_t)(u.pm * BM + wr * 64 + fr) * D + u.pn * BM + wc * 32 + 8 * fq;
#pragma unroll
        for (int ai = 0; ai < 2; ++ai)
#pragma unroll
            for (int m = 0; m < 4; ++m)
#pragma unroll
                for (int bj = 0; bj < 2; ++bj) p.hw[ai][m][bj] = *(const u32x4*)(base + (size_t)(ai * HALF + m * 16) * D + bj * HALF);
    }
    __device__ __forceinline__ void operator()(const Acc& acc, const Unit& u, int wr, int wc, int fr, int fq, const Pre& p) const {
        const int row0 = u.pm * BM + wr * 64 + fr;
        bf16_t* base = hb + (size_t)row0 * D + u.pn * BM + wc * 32 + 8 * fq;
        const u32x4 (&hw)[2][4][2] = p.hw;
#pragma unroll
        for (int ai = 0; ai < 2; ++ai)
#pragma unroll
            for (int m = 0; m < 4; ++m) { float ss = 0.f;
#pragma unroll
                for (int bj = 0; bj < 2; ++bj) { f32x4 h0, h1; unpack8(hw[ai][m][bj], h0, h1);
                    h0 = h0 + acc[ai][bj][m][0] * scale; h1 = h1 + acc[ai][bj][m][1] * scale;
                    *(u32x4*)(base + (size_t)(ai * HALF + m * 16) * D + bj * HALF) = pack8(h0, h1); ss += sumsq8(h0, h1); }
                ss = xsum_fq(ss);
                if (fq == 0) Pout[(size_t)(row0 + ai * HALF + m * 16) * 16 + u.pn * 4 + wc] = ss; }
    }
};
struct EpiGlu { static constexpr int NST = 16;
    static constexpr bool HASPRE = true;
    struct Pre { u32x4 hw[2][4]; };
    bf16_t* hb; float* Pout;
    __device__ __forceinline__ void pre(Pre& p, const Unit& u, int wr, int wc, int fr, int fq) const {
        const bf16_t* base = hb + (size_t)(u.pm * BM + wr * 64 + fr) * D + u.pn * 128 + wc * 32 + 8 * fq;
#pragma unroll
        for (int ai = 0; ai < 2; ++ai)
#pragma unroll
            for (int m = 0; m < 4; ++m) p.hw[ai][m] = *(const u32x4*)(base + (size_t)(ai * HALF + m * 16) * D);
    }
    __device__ __forceinline__ void operator()(const Acc& acc, const Unit& u, int wr, int wc, int fr, int fq, const Pre& p) const {
        const int row0 = u.pm * BM + wr * 64 + fr;
        bf16_t* base = hb + (size_t)row0 * D + u.pn * 128 + wc * 32 + 8 * fq;
        const u32x4 (&hw)[2][4] = p.hw;
#pragma unroll
        for (int ai = 0; ai < 2; ++ai)
#pragma unroll
            for (int m = 0; m < 4; ++m) { f32x4 h0, h1; unpack8(hw[ai][m], h0, h1);
#pragma unroll
                for (int c = 0; c < 4; c += 2) {
                    const f32x2 v0 = pk_gate((f32x2){acc[ai][0][m][0][c], acc[ai][0][m][0][c + 1]}, (f32x2){acc[ai][1][m][0][c], acc[ai][1][m][0][c + 1]}, -1.4426950408889634f);
                    const f32x2 v1 = pk_gate((f32x2){acc[ai][0][m][1][c], acc[ai][0][m][1][c + 1]}, (f32x2){acc[ai][1][m][1][c], acc[ai][1][m][1][c + 1]}, -1.4426950408889634f);
                    h0[c] += v0.x; h0[c + 1] += v0.y; h1[c] += v1.x; h1[c + 1] += v1.y; }
                *(u32x4*)(base + (size_t)(ai * HALF + m * 16) * D) = pack8(h0, h1);
                float ss = xsum_fq(sumsq8(h0, h1));
                if (fq == 0) (Pout + (size_t)(u.pn >> 2) * (2 * MiB / 4))[(size_t)(row0 + ai * HALF + m * 16) * 16 + (u.pn & 3) * 4 + wc] = ss; }
    }
};
template <int NPIN> struct EpiPle { static constexpr bool HASPRE = false; static constexpr int NST = 24;
    const bf16_t* hin; bf16_t* hout; const bf16_t* pp; const float* Pin; float* Pout; RsTab rt;
    __device__ __forceinline__ void operator()(const Acc& acc, const Unit& u, int wr, int wc, int fr, int fq) const {
        const int row0 = u.pm * BM + wr * 64 + fr; float rs[2][4]; rs_fetch<NPIN>(rt, Pin, u, wr, wc, fr, fq, rs);
#pragma unroll
        for (int ai = 0; ai < 2; ++ai)
#pragma unroll
            for (int m = 0; m < 4; ++m) { const int row = row0 + ai * HALF + m * 16; float ss = 0.f; const float r = rs[ai][m];
#pragma unroll
                for (int bj = 0; bj < 2; ++bj) { const size_t off = (size_t)row * D + u.pn * BM + bj * HALF + wc * 32 + 8 * fq;
                    f32x4 h0, h1, p0, p1; unpack8(*(const u32x4*)(hin + off), h0, h1); unpack8(*(const u32x4*)(pp + off), p0, p1);
#pragma unroll
                    for (int c = 0; c < 4; c += 2) { const float c1 = r * -1.4426950408889634f;
                        const f32x2 v0 = pk_gate((f32x2){p0[c], p0[c + 1]}, (f32x2){acc[ai][bj][m][0][c], acc[ai][bj][m][0][c + 1]}, c1);
                        const f32x2 v1 = pk_gate((f32x2){p1[c], p1[c + 1]}, (f32x2){acc[ai][bj][m][1][c], acc[ai][bj][m][1][c + 1]}, c1);
                        h0[c] += v0.x; h0[c + 1] += v0.y; h1[c] += v1.x; h1[c + 1] += v1.y; }
                    *(u32x4*)(hout + off) = pack8(h0, h1); ss += sumsq8(h0, h1); }
                ss = xsum_fq(ss);
                if (fq == 0) Pout[(size_t)row * 16 + u.pn * 4 + wc] = ss; }
    }
};
struct EpiPlain { static constexpr bool HASPRE = false; static constexpr int NST = 16;
    bf16_t* O; int ldc;
    __device__ __forceinline__ void operator()(const Acc& acc, const Unit& u, int wr, int wc, int fr, int fq) const {
        const int row0 = u.pm * BM + wr * 64 + fr;
#pragma unroll
        for (int ai = 0; ai < 2; ++ai)
#pragma unroll
            for (int m = 0; m < 4; ++m)
#pragma unroll
                for (int bj = 0; bj < 2; ++bj)
                    *(u32x4*)(O + (size_t)(row0 + ai * HALF + m * 16) * ldc + u.pn * BM + bj * HALF + wc * 32 + 8 * fq) = pack8(acc[ai][bj][m][0], acc[ai][bj][m][1]);
    }
};
template <int NPIN> struct EpiWin { static constexpr bool HASPRE = false; static constexpr int NST = 16;
    unsigned char* big; const float* P; RsTab rt;
    __device__ __forceinline__ void operator()(const Acc& acc, const Unit& u, int wr, int wc, int fr, int fq) const {
        const int row0 = u.pm * BM + wr * 64 + fr; float rs[2][4]; rs_fetch<NPIN>(rt, P, u, wr, wc, fr, fq, rs);
#pragma unroll
        for (int ai = 0; ai < 2; ++ai)
#pragma unroll
            for (int m = 0; m < 4; ++m) { const int tok = row0 + ai * HALF + m * 16; const float r = rs[ai][m];
#pragma unroll
                for (int bj = 0; bj < 2; ++bj) { const int ch = u.pn * BM + bj * HALF + wc * 32 + 8 * fq; const int gI = ch >> 4, hi0 = ch & 15;
                    *(u32x4*)((bf16_t*)(big + (size_t)(tok >> 12) * SLICE) + (size_t)(gI * 256 + ((tok >> 4) & 255)) * A5K + (tok & 15) * 16 + hi0) = pack8(acc[ai][bj][m][0] * r, acc[ai][bj][m][1] * r); } }
    }
};
struct EpiSloc { static constexpr bool HASPRE = false; static constexpr int NST = 16;
    unsigned char* big;
    __device__ __forceinline__ void operator()(const Acc& acc, const Unit& u, int wr, int wc, int fr, int fq) const {
        const int rl0 = wr * 64 + fr; float* S = (float*)(big + (size_t)u.pm * SLICE + SLOC_OFF);
#pragma unroll
        for (int ai = 0; ai < 2; ++ai)
#pragma unroll
            for (int m = 0; m < 4; ++m) { float* o = S + (size_t)(u.grp * 256 + rl0 + ai * HALF + m * 16) * 128 + wc * 32 + 8 * fq;
                *(f32x4*)o = acc[ai][0][m][0]; *(f32x4*)(o + 4) = acc[ai][0][m][1]; }
    }
};
struct EpiY { static constexpr bool HASPRE = false; static constexpr int NST = 16;
    const unsigned char* big; const float* dsk; bf16_t* Z;
    __device__ __forceinline__ void operator()(const Acc& acc, const Unit& u, int wr, int wc, int fr, int fq) const {
        const int rl0 = wr * 64 + fr; const int gI = u.grp; const bf16_t* A5 = (const bf16_t*)(big + (size_t)u.pm * SLICE);
#pragma unroll
        for (int bj = 0; bj < 2; ++bj) { const int n0 = bj * HALF + wc * 32 + 8 * fq, tl = n0 >> 4, ho0 = n0 & 15;
            const f32x4 d0 = *(const f32x4*)(dsk + gI * 16 + ho0), d1 = *(const f32x4*)(dsk + gI * 16 + ho0 + 4);
#pragma unroll
            for (int ai = 0; ai < 2; ++ai)
#pragma unroll
                for (int m = 0; m < 4; ++m) { const int rl = rl0 + ai * HALF + m * 16, R = u.pm * BM + rl;
                    const u32x4 uw = *(const u32x4*)(A5 + (size_t)(gI * 256 + rl) * A5K + n0);
                    f32x4 y0 = acc[ai][bj][m][0], y1 = acc[ai][bj][m][1];
                    y0[0] += d0[0] * bf_lo(uw.x); y0[1] += d0[1] * bf_hi(uw.x); y0[2] += d0[2] * bf_lo(uw.y); y0[3] += d0[3] * bf_hi(uw.y);
                    y1[0] += d1[0] * bf_lo(uw.z); y1[1] += d1[1] * bf_hi(uw.z); y1[2] += d1[2] * bf_lo(uw.w); y1[3] += d1[3] * bf_hi(uw.w);
#pragma unroll
                    for (int c = 0; c < 4; c += 2) {
                        const f32x2 a = {y0[c], y0[c + 1]}, b = {y1[c], y1[c + 1]};
                        const f32x2 va = pk_gate(a, a * (a * a * 0.044715f + 1.0f), -2.3022081983f), vb = pk_gate(b, b * (b * b * 0.044715f + 1.0f), -2.3022081983f);
                        y0[c] = va.x; y0[c + 1] = va.y; y1[c] = vb.x; y1[c + 1] = vb.y; }
                    *(u32x4*)(Z + (size_t)(R * 16 + tl) * D + gI * 16 + ho0) = pack8(y0, y1);
                    asm volatile("" ::: "memory"); } }
    }
};
template <int NPIN> struct EpiQK { static constexpr bool HASPRE = false; static constexpr int NST = 16;
    bf16_t* Q; unsigned char* big; const float* P; RsTab rt;
    __device__ __forceinline__ void operator()(const Acc& acc, const Unit& u, int wr, int wc, int fr, int fq) const {
        const int row0 = u.pm * BM + wr * 64 + fr; float rs[2][4]; rs_fetch<NPIN>(rt, P, u, wr, wc, fr, fq, rs);
        bf16_t* base = (u.pn < 4) ? Q : (bf16_t*)(big + (size_t)(u.pm >> 4) * SLICE) - (size_t)(u.pm >> 4) * 4096 * D; const float sc = (u.pn < 4) ? QSCALE : 1.0f;
#pragma unroll
        for (int ai = 0; ai < 2; ++ai)
#pragma unroll
            for (int m = 0; m < 4; ++m) { const float r = rs[ai][m] * sc;
#pragma unroll
                for (int bj = 0; bj < 2; ++bj)
                    *(u32x4*)(base + (size_t)(row0 + ai * HALF + m * 16) * D + (u.pn & 3) * BM + bj * HALF + wc * 32 + 8 * fq) = pack8(acc[ai][bj][m][0] * r, acc[ai][bj][m][1] * r); }
    }
};
template <int NPIN> struct EpiVt { static constexpr bool HASPRE = false; static constexpr int NST = 16;
    bf16_t* Vt; const float* P;
    __device__ __forceinline__ void operator()(const Acc& acc, const Unit& u, int wr, int wc, int fr, int fq) const {
        const int lane = fq * 16 + fr; const int row0 = u.pm * BM + wr * 64 + fr;
        float myrs; { const int tok = u.pn * BM + (lane >> 5) * HALF + wc * 32 + (lane & 31); const f32x4* p = (const f32x4*)(P + (size_t)tok * NPIN); float s = 0.f;
#pragma unroll
            for (int j = 0; j < NPIN / 4; ++j) { f32x4 v = p[j]; s += (v[0] + v[1]) + (v[2] + v[3]); }
            myrs = rsqrtf(s * (1.0f / D) + EPS); }
        float rsv[2][8];
#pragma unroll
        for (int bj = 0; bj < 2; ++bj)
#pragma unroll
            for (int e = 0; e < 8; ++e) rsv[bj][e] = __builtin_bit_cast(float, __builtin_amdgcn_ds_bpermute((bj * 32 + 8 * fq + e) << 2, __builtin_bit_cast(int, myrs)));
#pragma unroll
        for (int ai = 0; ai < 2; ++ai)
#pragma unroll
            for (int m = 0; m < 4; ++m)
#pragma unroll
                for (int bj = 0; bj < 2; ++bj) { f32x4 a = acc[ai][bj][m][0], b = acc[ai][bj][m][1];
#pragma unroll
                    for (int c = 0; c < 4; ++c) { a[c] *= rsv[bj][c]; b[c] *= rsv[bj][4 + c]; }
                    *(u32x4*)((bf16_t*)((unsigned char*)Vt + (size_t)(u.pn >> 4) * VT_SLICE) + (size_t)(row0 + ai * HALF + m * 16) * 4096 + (u.pn & 15) * BM + bj * HALF + wc * 32 + 8 * fq) = pack8(a, b); }
    }
};
}

struct Params {
    const float* in[27]; float* out; unsigned char* ws; int ph_lo, ph_hi;
};

__device__ __forceinline__ void transpose_item(const float* W, int K, int N, const float* gain, bf16_t* WT, int mode, int off, LAS float* scr, int item, int lane) {
    const int nblk = N / 32, kb = item / nblk, nb = item % nblk, k0 = 64 * kb, n0 = 32 * nb;
    float wv[32];
#pragma unroll
    for (int i = 0; i < 32; ++i) wv[i] = W[(size_t)(k0 + 2 * i + (lane >> 5)) * N + n0 + (lane & 31)];
    if (gain) {
#pragma unroll
        for (int i = 0; i < 32; ++i) wv[i] *= gain[k0 + 2 * i + (lane >> 5)]; }
#pragma unroll
    for (int i = 0; i < 32; ++i) scr[(2 * i + (lane >> 5)) * 33 + (lane & 31)] = wv[i];
    asm volatile("s_waitcnt lgkmcnt(0)" ::: "memory");
    const int c = lane & 7;
    int d0;
    if (mode == 0) d0 = n0;
    else if (mode == 1) d0 = (n0 / 128) * 256 + off + (n0 % 128);
    else { const int half = n0 / 1024, cc = n0 % 1024; d0 = (cc / 128) * 256 + half * 128 + (cc % 128); }
#pragma unroll
    for (int j = 0; j < 4; ++j) { const int n = (lane >> 3) + 8 * j; const LAS float* s = scr + (8 * c) * 33 + n;
        u32x4 o; o.x = cvt_pk_bf16(s[0 * 33], s[1 * 33]); o.y = cvt_pk_bf16(s[2 * 33], s[3 * 33]); o.z = cvt_pk_bf16(s[4 * 33], s[5 * 33]); o.w = cvt_pk_bf16(s[6 * 33], s[7 * 33]);
        *(u32x4*)(WT + (size_t)(d0 + n) * K + k0 + 8 * c) = o; }
    asm volatile("s_waitcnt lgkmcnt(0)" ::: "memory");
}

__device__ __forceinline__ void weight_item(const Params& P, int it, LAS float* scr, int lane) {
    unsigned char* ws = P.ws;
    constexpr int IU = (D / 64) * (FF / 32);
    if (it < 12 * IU) {
        const int j = it / IU, r = it % IU, li = j / 6, rr = j % 6, w = rr / 3, t = rr % 3;
        if (t < 2) { const float* src = P.in[(w ? 8 : 3) + t] + (size_t)li * D * FF; const float* gain = P.in[w ? 7 : 2] + li * D;
            transpose_item(src, D, FF, gain, (bf16_t*)(ws + WS_WUP + (size_t)(li * 2 + w) * SZ_WUP), 1, t * 128, scr, r, lane); }
        else { const float* src = P.in[w ? 10 : 5] + (size_t)li * FF * D;
            transpose_item(src, FF, D, nullptr, (bf16_t*)(ws + WS_WDN + (size_t)(li * 2 + w) * SZ_WDN), 0, 0, scr, r, lane); }
        return;
    }
    it -= 12 * IU;
    if (it < 1280) { const int li = it / 640, r2 = it % 640;
        if (r2 < 512) transpose_item(P.in[13] + (size_t)li * D * D, D, D, P.in[11] + li * D, (bf16_t*)(ws + WS_WG + (size_t)li * 2 * MiB), 0, 0, scr, r2, lane);
        else transpose_item(P.in[12] + (size_t)li * PD * D, PD, D, nullptr, (bf16_t*)(ws + WS_WP + (size_t)li * (MiB / 2)), 0, 0, scr, r2 - 512, lane);
        return; }
    it -= 1280;
    if (it < 512) { transpose_item(P.in[14], D, D, P.in[6], (bf16_t*)(ws + WS_WIN), 0, 0, scr, it, lane); return; }
    if (it < 1536) { transpose_item(P.in[23], D, 2 * D, nullptr, (bf16_t*)(ws + WS_WGLU), 2, 0, scr, it - 512, lane); return; }
    if (it < 3072) { transpose_item(P.in[24], D, 3 * D, P.in[6] + D, (bf16_t*)(ws + WS_WQKV), 0, 0, scr, it - 1536, lane); return; }
    transpose_item(P.in[25], D, D, nullptr, (bf16_t*)(ws + WS_WO), 0, 0, scr, it - 3072, lane);
}
constexpr int N_WITEMS = 12 * 1408 + 1280 + 3584;

__device__ __forceinline__ void s5_setup_group(const Params& P, int g, int part, int nparts, LAS float* lds, int wv) {
    LAS float* PW = lds;
    LAS float* BB = PW + 17 * 128;
    LAS float* CC = BB + 2048;
    LAS float* KT = CC + 2048;
    const int tid = otid(wv);
    bf16_t* Bst = (bf16_t*)(P.ws + WS_BST) + (size_t)g * 128 * 256;
    bf16_t* Bcat = (bf16_t*)(P.ws + WS_BCAT) + (size_t)g * 256 * A5K;
    float* ab16 = (float*)(P.ws + WS_AB16);
    if (tid < 64) {
        const int p = tid;
        double lre = (double)P.in[15][g * 64 + p]; if (lre > -1e-4) lre = -1e-4;
        const double lim = (double)P.in[16][g * 64 + p];
        const double dt = exp((double)P.in[17][g]);
        const double mag = exp(lre * dt);
        double x = lim * dt; const double twopi = 6.283185307179586476925; x -= twopi * rint(x / twopi);
        const double y = x * (1.0 / 16.0), y2 = y * y;
        double sn = y * (1.0 - y2 / 6.0 * (1.0 - y2 / 20.0 * (1.0 - y2 / 42.0 * (1.0 - y2 / 72.0 * (1.0 - y2 / 110.0 * (1.0 - y2 / 156.0))))));
        double cs = 1.0 - y2 / 2.0 * (1.0 - y2 / 12.0 * (1.0 - y2 / 30.0 * (1.0 - y2 / 56.0 * (1.0 - y2 / 90.0 * (1.0 - y2 / 132.0 * (1.0 - y2 / 182.0))))));
#pragma unroll
        for (int k = 0; k < 4; ++k) { const double s2 = 2.0 * sn * cs, c2 = cs * cs - sn * sn; sn = s2; cs = c2; }
        const double ar = mag * cs, ai = mag * sn;
        const double nr = ar - 1.0, ni = ai, den = lre * lre + lim * lim;
        const double fr = (nr * lre + ni * lim) / den, fi = (ni * lre - nr * lim) / den;
        double pr = 1.0, pi = 0.0;
        for (int tau = 0; tau <= 16; ++tau) { PW[(tau * 64 + p) * 2] = (float)pr; PW[(tau * 64 + p) * 2 + 1] = (float)pi; const double npr = pr * ar - pi * ai, npi = pr * ai + pi * ar; pr = npr; pi = npi; }
        if (part == 0) { ab16[(g * 64 + p) * 2] = PW[(16 * 64 + p) * 2]; ab16[(g * 64 + p) * 2 + 1] = PW[(16 * 64 + p) * 2 + 1]; }
        for (int hi = 0; hi < 16; ++hi) { const double br = (double)P.in[18][(size_t)(g * 64 + p) * 16 + hi], bi = (double)P.in[19][(size_t)(g * 64 + p) * 16 + hi];
            BB[(p * 16 + hi) * 2] = (float)(fr * br - fi * bi); BB[(p * 16 + hi) * 2 + 1] = (float)(fr * bi + fi * br); }
    }
    for (int i = tid; i < 1024; i += NTHREADS) { CC[i * 2] = P.in[20][(size_t)g * 1024 + i]; CC[i * 2 + 1] = P.in[21][(size_t)g * 1024 + i]; }
    __syncthreads();
    if (tid < 256) { const int tau = tid >> 4, ho = tid & 15; float a[16];
#pragma unroll
        for (int hi = 0; hi < 16; ++hi) a[hi] = 0.f;
        for (int p = 0; p < 64; ++p) { const float cr = CC[(ho * 64 + p) * 2], ci = CC[(ho * 64 + p) * 2 + 1], pr = PW[(tau * 64 + p) * 2], pi = PW[(tau * 64 + p) * 2 + 1];
            const float wr = cr * pr - ci * pi, wi = cr * pi + ci * pr;
#pragma unroll
            for (int hi = 0; hi < 16; ++hi) a[hi] += wr * BB[(p * 16 + hi) * 2] - wi * BB[(p * 16 + hi) * 2 + 1]; }
#pragma unroll
        for (int hi = 0; hi < 16; ++hi) KT[(tau * 16 + ho) * 16 + hi] = a[hi]; }
    __syncthreads();
    const int bst_rows = 128 / nparts, bcat_rows = 256 / nparts;
    for (int idx = tid; idx < bst_rows * 32; idx += NTHREADS) { const int n = part * bst_rows + (idx >> 5), k0 = (idx & 31) * 8, j = k0 >> 4, hi0 = k0 & 15; float v[8];
        { const int p = n >> 1, ri = n & 1; const float pr = PW[((15 - j) * 64 + p) * 2], pi = PW[((15 - j) * 64 + p) * 2 + 1];
#pragma unroll
            for (int e = 0; e < 8; ++e) { const float br = BB[(p * 16 + hi0 + e) * 2], bi = BB[(p * 16 + hi0 + e) * 2 + 1]; v[e] = ri ? (pr * bi + pi * br) : (pr * br - pi * bi); } }
        u32x4 o; o.x = cvt_pk_bf16(v[0], v[1]); o.y = cvt_pk_bf16(v[2], v[3]); o.z = cvt_pk_bf16(v[4], v[5]); o.w = cvt_pk_bf16(v[6], v[7]);
        *(u32x4*)(Bst + (size_t)n * 256 + k0) = o; }
    for (int idx = tid; idx < bcat_rows * 48; idx += NTHREADS) { const int n = part * bcat_rows + idx / 48, k0 = (idx % 48) * 8, tl = n >> 4, ho = n & 15; float v[8];
        if (k0 < 256) { const int j = k0 >> 4, hi0 = k0 & 15;
#pragma unroll
            for (int e = 0; e < 8; ++e) v[e] = (tl >= j) ? KT[((tl - j) * 16 + ho) * 16 + hi0 + e] : 0.f; }
        else { const int kk0 = k0 - 256;
#pragma unroll
            for (int e = 0; e < 8; ++e) { const int kk = kk0 + e, p = kk >> 1, ri = kk & 1; const float cr = CC[(ho * 64 + p) * 2], ci = CC[(ho * 64 + p) * 2 + 1], pr = PW[((tl + 1) * 64 + p) * 2], pi = PW[((tl + 1) * 64 + p) * 2 + 1];
                v[e] = ri ? -(cr * pi + ci * pr) : (cr * pr - ci * pi); } }
        u32x4 o; o.x = cvt_pk_bf16(v[0], v[1]); o.y = cvt_pk_bf16(v[2], v[3]); o.z = cvt_pk_bf16(v[4], v[5]); o.w = cvt_pk_bf16(v[6], v[7]);
        *(u32x4*)(Bcat + (size_t)n * A5K + k0) = o; }
    __syncthreads();
}

__device__ __forceinline__ void prologue(const Params& P, LAS unsigned char* lds, int wv) {
    const int tid = otid(wv), lane = tid & 63, wave = wv, G = gridDim.x;
    { const int nparts = (G >= 4 * NG) ? 4 : 1; for (int j = blockIdx.x; j < NG * nparts; j += G) s5_setup_group(P, j / nparts, j % nparts, nparts, (LAS float*)lds, wv); }
    const int gw = blockIdx.x * NWAVES + wave, NGW = G * NWAVES;
    LAS float* scr = (LAS float*)(lds + wave * 16384);
    for (int it = gw; it < N_WITEMS; it += NGW) weight_item(P, it, scr, lane);
    const float* x = P.in[0]; bf16_t* hb = (bf16_t*)(P.ws + WS_HB); float* ssq = (float*)(P.ws + WS_SSQ);
    for (int m = gw; m < T; m += 2 * NGW) {
        const int m2 = m + NGW; const bool has2 = m2 < T;
        const f32x4* xr = (const f32x4*)(x + (size_t)m * D) + lane; const f32x4* xr2 = (const f32x4*)(x + (size_t)(has2 ? m2 : m) * D) + lane; f32x4 v[4], v2[4]; float s = 0.f, s2 = 0.f;
#pragma unroll
        for (int j = 0; j < 4; ++j) { v[j] = xr[64 * j]; v2[j] = xr2[64 * j]; }
#pragma unroll
        for (int j = 0; j < 4; ++j) { s += (v[j][0] * v[j][0] + v[j][1] * v[j][1]) + (v[j][2] * v[j][2] + v[j][3] * v[j][3]); s2 += (v2[j][0] * v2[j][0] + v2[j][1] * v2[j][1]) + (v2[j][2] * v2[j][2] + v2[j][3] * v2[j][3]); }
        s = wave_sum(s); s2 = wave_sum(s2);
        u32x2* o = (u32x2*)(hb + (size_t)m * D) + lane;
#pragma unroll
        for (int j = 0; j < 4; ++j) { u32x2 w; w.x = cvt_pk_bf16(v[j][0], v[j][1]); w.y = cvt_pk_bf16(v[j][2], v[j][3]); o[64 * j] = w; }
        if (lane < 16) ssq[(size_t)m * 16 + lane] = (lane == 0) ? s : 0.f;
        if (has2) { u32x2* o2 = (u32x2*)(hb + (size_t)m2 * D) + lane;
#pragma unroll
            for (int j = 0; j < 4; ++j) { u32x2 w; w.x = cvt_pk_bf16(v2[j][0], v2[j][1]); w.y = cvt_pk_bf16(v2[j][2], v2[j][3]); o2[64 * j] = w; }
            if (lane < 16) ssq[(size_t)m2 * 16 + lane] = (lane == 0) ? s2 : 0.f; }
    }
    const f32x4* pp = (const f32x4*)P.in[1]; u32x2* pb = (u32x2*)(P.ws + WS_PB);
    const size_t n4 = (size_t)2 * T * PD / 4;
    const size_t st = (size_t)G * NTHREADS;
    for (size_t i = (size_t)blockIdx.x * NTHREADS + tid; i < n4; i += 4 * st) { f32x4 v[4];
#pragma unroll
        for (int j = 0; j < 4; ++j) if (i + j * st < n4) v[j] = pp[i + j * st];
#pragma unroll
        for (int j = 0; j < 4; ++j) if (i + j * st < n4) { u32x2 w; w.x = cvt_pk_bf16(v[j][0], v[j][1]); w.y = cvt_pk_bf16(v[j][2], v[j][3]); pb[i + j * st] = w; } }
}

__device__ __forceinline__ void s5_scan(const Params& P, int wv, bool grp_mode) {
    const int lane = olane(), wave = wv;
    const float* ab16 = (const float*)(P.ws + WS_AB16);
    const int pstart = grp_mode ? (wave < 4 ? ((int)(blockIdx.x & 7) * 128 + (int)(blockIdx.x >> 3) * 4 + wave) : NB * NG) : (int)(blockIdx.x + gridDim.x * wave);
    const int pstep = grp_mode ? NB * NG : (int)(gridDim.x * NWAVES);
    for (int pair = pstart; pair < NB * NG; pair += pstep) {
        const int b = pair / NG, g = pair % NG, p = lane;
        const float ar = ab16[(g * 64 + p) * 2], ai = ab16[(g * 64 + p) * 2 + 1];
        float sr = 0.f, si = 0.f;
        unsigned char* slice = P.ws + WS_BIG + (size_t)(b >> 1) * SLICE; const int rl0 = (b & 1) * NCH;
        const f32x2* src = (const f32x2*)((const float*)(slice + SLOC_OFF) + (size_t)(g * 256 + rl0) * 128) + p;
        unsigned* dst = (unsigned*)((bf16_t*)slice + (size_t)(g * 256 + rl0) * A5K + 256) + p;
        for (int c0 = 0; c0 < NCH; c0 += 32) {
            f32x2 v[32];
#pragma unroll
            for (int j = 0; j < 32; ++j) v[j] = src[(size_t)(c0 + j) * 64];
#pragma unroll
            for (int j = 0; j < 32; ++j) { dst[(size_t)(c0 + j) * (A5K / 2)] = cvt_pk_bf16(sr, si);
                const float nr = ar * sr - ai * si + v[j][0], ni = ar * si + ai * sr + v[j][1]; sr = nr; si = ni; }
        }
    }
}

__device__ __forceinline__ float shfl32(float v, int hi) { auto rr = __builtin_amdgcn_permlane32_swap(__float_as_uint(v), __float_as_uint(v), false, false); return hi ? __uint_as_float(rr[0]) : __uint_as_float(rr[1]); }
__device__ __forceinline__ void attn_phase(const Params& P, bf16_t* QO, int wv, bool grp_mode, LAS unsigned char* lds) {
    const int lane = olane(), wave = wv, r32 = lane & 31, hi = lane >> 5;
    LAS unsigned char* wl = lds + wave * 10240;
    const bf16_t* Q = QO; bf16_t* O = QO;
    const int NGW = grp_mode ? 256 : (int)(gridDim.x * NWAVES);
    const int ustart = grp_mode ? ((int)(blockIdx.x >> 3) * NWAVES + wave) : (int)(blockIdx.x + gridDim.x * wave);
    const int uend = grp_mode ? 2048 : NB * 16 * 64, ubase = grp_mode ? (int)(blockIdx.x & 7) * 2048 : 0;
    for (int ul = ustart; ul < uend; ul += NGW) {
        const int unit = ubase + ul;
        const int bh = unit >> 6, qb = unit & 63, b = bh >> 4, h = bh & 15, q0 = qb * 32; const size_t tokbase = (size_t)b * SEQ;
        const bf16_t* Kk = (const bf16_t*)(P.ws + WS_BIG + (size_t)(b >> 1) * SLICE) + (size_t)(b & 1) * SEQ * D;
        const bf16_t* Vt = (const bf16_t*)(P.ws + WS_EXTRA + (size_t)(b >> 1) * VT_SLICE) + (size_t)(b & 1) * SEQ;
        bf16x8 qf[4];
        {
            u32x4 qq[4];
#pragma unroll
            for (int j = 0; j < 4; ++j) qq[j] = *(const u32x4*)(Q + (tokbase + q0 + (lane >> 3) + 8 * j) * D + h * 64 + (lane & 7) * 8);
#pragma unroll
            for (int j = 0; j < 4; ++j) *(LAS u32x4*)(wl + ((lane >> 3) + 8 * j) * 144 + (lane & 7) * 16) = qq[j];
#pragma unroll
            for (int d0 = 0; d0 < 4; ++d0) qf[d0] = *(const LAS bf16x8*)(wl + r32 * 144 + d0 * 32 + hi * 16);
        }
        f32x16 o0 = {}, o1 = {}; float carry = 1.0f;
        u32x4 kq[4], vq[4];
#define ATT_LOAD(KT) do { const int kv0_ = (KT) * 32; \
            _Pragma("unroll") for (int j = 0; j < 4; ++j) { kq[j] = *(const u32x4*)(Kk + (size_t)(kv0_ + (lane >> 3) + 8 * j) * D + h * 64 + (lane & 7) * 8); \
                                                            vq[j] = *(const u32x4*)(Vt + (size_t)(h * 64 + (lane >> 2) + 16 * j) * 4096 + kv0_ + (lane & 3) * 8); } } while (0)
        ATT_LOAD(qb);
        for (int kt = qb; kt >= 0; --kt) {
            bf16x8 kf[4]; u32x2 vlo[2][2], vhi[2][2];
#pragma unroll
            for (int j = 0; j < 4; ++j) { *(LAS u32x4*)(wl + ((lane >> 3) + 8 * j) * 144 + (lane & 7) * 16) = kq[j]; *(LAS u32x4*)(wl + 4608 + ((lane >> 2) + 16 * j) * 80 + (lane & 3) * 16) = vq[j]; }
            { const int ktn = kt > 0 ? kt - 1 : 0; ATT_LOAD(ktn); }
#pragma unroll
            for (int d0 = 0; d0 < 4; ++d0) kf[d0] = *(const LAS bf16x8*)(wl + r32 * 144 + d0 * 32 + hi * 16);
#pragma unroll
            for (int db = 0; db < 2; ++db)
#pragma unroll
                for (int kk = 0; kk < 2; ++kk) { const LAS unsigned char* vp = wl + 4608 + (db * 32 + r32) * 80 + kk * 32 + hi * 8; vlo[db][kk] = *(const LAS u32x2*)vp; vhi[db][kk] = *(const LAS u32x2*)(vp + 16); }
            f32x16 s = {};
#pragma unroll
            for (int d0 = 0; d0 < 4; ++d0) s = __builtin_amdgcn_mfma_f32_32x32x16_bf16(kf[d0], qf[d0], s, 0, 0, 0);
            float kp[16], sg[16];
#pragma unroll
            for (int r = 0; r < 16; ++r) { const float t = __builtin_amdgcn_exp2f(fminf(s[r], 80.0f)); const float rr = fast_rcp(1.0f + t); kp[r] = rr; sg[r] = t * rr; }
            if (kt == qb) {
#pragma unroll
                for (int r = 0; r < 16; ++r) { const int i = (r & 3) + 8 * (r >> 2) + 4 * hi; if (i >= r32) { kp[r] = 1.0f; sg[r] = 0.f; } }
            }
            float ex[16], tot[4];
#pragma unroll
            for (int bq = 0; bq < 4; ++bq) { ex[4 * bq + 3] = 1.0f; ex[4 * bq + 2] = kp[4 * bq + 3]; ex[4 * bq + 1] = ex[4 * bq + 2] * kp[4 * bq + 2]; ex[4 * bq] = ex[4 * bq + 1] * kp[4 * bq + 1]; tot[bq] = ex[4 * bq] * kp[4 * bq]; }
            float pt[4], Y[4];
#pragma unroll
            for (int bq = 0; bq < 4; ++bq) pt[bq] = shfl32(tot[bq], hi);
            Y[3] = carry; Y[2] = Y[3] * (tot[3] * pt[3]); Y[1] = Y[2] * (tot[2] * pt[2]); Y[0] = Y[1] * (tot[1] * pt[1]); carry = Y[0] * (tot[0] * pt[0]);
            float att[16];
#pragma unroll
            for (int bq = 0; bq < 4; ++bq) { const float X = hi ? Y[bq] : Y[bq] * pt[bq];
#pragma unroll
                for (int w = 0; w < 4; ++w) att[4 * bq + w] = sg[4 * bq + w] * (X * ex[4 * bq + w]); }
            bf16x8 pb[2];
#pragma unroll
            for (int kk = 0; kk < 2; ++kk) { u32x4 w; w.x = cvt_pk_bf16(att[8 * kk], att[8 * kk + 1]); w.y = cvt_pk_bf16(att[8 * kk + 2], att[8 * kk + 3]); w.z = cvt_pk_bf16(att[8 * kk + 4], att[8 * kk + 5]); w.w = cvt_pk_bf16(att[8 * kk + 6], att[8 * kk + 7]);
                pb[kk] = __builtin_bit_cast(bf16x8, w); }
#pragma unroll
            for (int kk = 0; kk < 2; ++kk) {
                u32x4 a0; a0.x = vlo[0][kk].x; a0.y = vlo[0][kk].y; a0.z = vhi[0][kk].x; a0.w = vhi[0][kk].y;
                u32x4 a1; a1.x = vlo[1][kk].x; a1.y = vlo[1][kk].y; a1.z = vhi[1][kk].x; a1.w = vhi[1][kk].y;
                o0 = __builtin_amdgcn_mfma_f32_32x32x16_bf16(__builtin_bit_cast(bf16x8, a0), pb[kk], o0, 0, 0, 0);
                o1 = __builtin_amdgcn_mfma_f32_32x32x16_bf16(__builtin_bit_cast(bf16x8, a1), pb[kk], o1, 0, 0, 0);
            }
            if (!__any(carry > 1e-16f)) break;
        }
#pragma unroll
        for (int rq = 0; rq < 4; ++rq) {
            u32x2 w0; w0.x = cvt_pk_bf16(o0[4 * rq], o0[4 * rq + 1]); w0.y = cvt_pk_bf16(o0[4 * rq + 2], o0[4 * rq + 3]); *(LAS u32x2*)(wl + r32 * 144 + (8 * rq + 4 * hi) * 2) = w0;
            u32x2 w1; w1.x = cvt_pk_bf16(o1[4 * rq], o1[4 * rq + 1]); w1.y = cvt_pk_bf16(o1[4 * rq + 2], o1[4 * rq + 3]); *(LAS u32x2*)(wl + r32 * 144 + 64 + (8 * rq + 4 * hi) * 2) = w1;
        }
#pragma unroll
        for (int j = 0; j < 4; ++j) { const u32x4 v = *(const LAS u32x4*)(wl + ((lane >> 3) + 8 * j) * 144 + (lane & 7) * 16);
            *(u32x4*)(O + (tokbase + q0 + (lane >> 3) + 8 * j) * D + h * 64 + (lane & 7) * 8) = v; }
    }
}

__device__ __forceinline__ void final_norm(const Params& P, const bf16_t* hb, const float* ssq, int wv, bool grp_mode) {
    const int lane = olane(), wave = wv;
    const int gw = grp_mode ? ((int)(blockIdx.x & 7) * 4096 + (int)(blockIdx.x >> 3) * NWAVES + wave) : (int)(blockIdx.x * NWAVES + wave), NGW = grp_mode ? 256 : (int)(gridDim.x * NWAVES);
    const int mend = grp_mode ? ((int)(blockIdx.x & 7) + 1) * 4096 : T;
    f32x4 gv[4];
#pragma unroll
    for (int j = 0; j < 2; ++j) { gv[2 * j] = *(const f32x4*)(P.in[26] + j * 512 + 8 * lane); gv[2 * j + 1] = *(const f32x4*)(P.in[26] + j * 512 + 8 * lane + 4); }
    for (int m = gw; m < mend; m += NGW) {
        float s = (lane < 16) ? ssq[(size_t)m * 16 + lane] : 0.f;
        const u32x4 w0 = *(const u32x4*)(hb + (size_t)m * D + 8 * lane), w1 = *(const u32x4*)(hb + (size_t)m * D + 512 + 8 * lane);
        s = wave_sum(s);
        const float rs = rsqrtf(s * (1.0f / D) + EPS);
        f32x4 a, b; float* o = P.out + (size_t)m * D + 8 * lane;
        pg8::unpack8(w0, a, b); *(f32x4*)o = a * rs * gv[0]; *(f32x4*)(o + 4) = b * rs * gv[1];
        pg8::unpack8(w1, a, b); *(f32x4*)(o + 512) = a * rs * gv[2]; *(f32x4*)(o + 516) = b * rs * gv[3];
    }
}


#define XB_TMO      128
#define XB_XCNT(j)  (256  + 64 * (j))
#define XB_XSUB(j)  (1280 + 64 * (j))
#define XB_XGEN(j)  (2304 + 64 * (j))
#define XB_TOP      3328
#define XB_TOPGEN   3392
#define XCD_BAR_WORDS 3456
#define XB_SPIN_CAP (1u << 18)
__device__ __forceinline__ unsigned xb_ld(unsigned* p)              { return __hip_atomic_load(p, __ATOMIC_RELAXED, __HIP_MEMORY_SCOPE_AGENT); }
__device__ __forceinline__ unsigned xb_add(unsigned* p, unsigned v) { return __hip_atomic_fetch_add(p, v, __ATOMIC_RELAXED, __HIP_MEMORY_SCOPE_AGENT); }
__device__ __forceinline__ unsigned xb_xcc_id() { return (unsigned)__builtin_amdgcn_s_getreg((3 << 11) | 20) & 0xFu; }
#define XB_SPIN(cond, bar) do { unsigned _sp = 0; while (cond) { __builtin_amdgcn_s_sleep(1); \
    if ((++_sp & 255u) == 0u) { if (xb_ld(&(bar)[XB_TMO])) break; if (_sp > XB_SPIN_CAP) { atomicAdd(&(bar)[XB_TMO], 1u); break; } } } } while (0)
struct XcdBarrier { unsigned* bar; unsigned x; volatile LAS unsigned* st; int wave; };
__device__ __forceinline__ bool xb_leader(const XcdBarrier& b) { return b.wave == 0 && olane() == 0; }
__device__ __forceinline__ XcdBarrier xcd_barrier_post(unsigned* bar, volatile LAS unsigned* st, int wv) {
    XcdBarrier b; b.bar = bar; b.x = xb_xcc_id(); b.st = st; b.wave = wv;
    if (xb_leader(b)) (void)xb_add(&bar[XB_XCNT(b.x)], 1u);
    return b;
}
__device__ __forceinline__ void xcd_barrier_complete(unsigned* bar, unsigned x, unsigned& nloc, unsigned& nx) {
    const unsigned G = gridDim.x * gridDim.y * gridDim.z;
    unsigned sum, cnt, mine, sp = 0u;
    for (;;) {
        sum = 0u; cnt = 0u; mine = 0u;
#pragma unroll
        for (unsigned j = 0; j < 16; ++j) { const unsigned c = xb_ld(&bar[XB_XCNT(j)]); sum += c; cnt += (c > 0u) ? 1u : 0u; mine = (j == x) ? c : mine; }
        if (sum == G) break;
        __builtin_amdgcn_s_sleep(1);
        if ((++sp & 255u) == 0u) { if (xb_ld(&bar[XB_TMO])) break; if (sp > XB_SPIN_CAP) { atomicAdd(&bar[XB_TMO], 1u); break; } }
    }
    nloc = mine > 0u ? mine : 1u; nx = cnt > 0u ? cnt : 1u;
}
__device__ __forceinline__ void xcd_barrier(const XcdBarrier& b) {
    asm volatile("s_waitcnt vmcnt(0)" ::: "memory");
    __syncthreads();
    if (xb_leader(b)) {
        unsigned* bar = b.bar;
        __builtin_amdgcn_s_waitcnt(0);
        unsigned nloc = b.st[0], nx = b.st[1];
        if (nloc == 0u) { xcd_barrier_complete(bar, b.x, nloc, nx); b.st[0] = nloc; b.st[1] = nx; }
        const unsigned old = xb_add(&bar[XB_XSUB(b.x)], 1u);
        const unsigned gen = old / nloc;
        if (old + 1u == (gen + 1u) * nloc) {
            __builtin_amdgcn_fence(__ATOMIC_RELEASE, "agent");
            asm volatile("s_waitcnt vmcnt(0)" ::: "memory");
            const unsigned og = xb_add(&bar[XB_TOP], 1u);
            const unsigned tg = og / nx;
            if (og + 1u == (tg + 1u) * nx) xb_add(&bar[XB_TOPGEN], 1u);
            else XB_SPIN(xb_ld(&bar[XB_TOPGEN]) == tg, bar);
            __builtin_amdgcn_fence(__ATOMIC_ACQUIRE, "agent");
            xb_add(&bar[XB_XGEN(b.x)], 1u);
            asm volatile("s_waitcnt vmcnt(0)" ::: "memory");
        } else {
            XB_SPIN(xb_ld(&bar[XB_XGEN(b.x)]) == gen, bar);
            __builtin_amdgcn_fence(__ATOMIC_ACQUIRE, "agent");
            asm volatile("s_waitcnt vmcnt(0)" ::: "memory");
        }
    }
    __syncthreads();
}

struct GrpBar { unsigned* cnt; unsigned target, n; int wave; bool same_xcc; };
__device__ __forceinline__ void grp_barrier(GrpBar& b) {
    asm volatile("s_waitcnt vmcnt(0)" ::: "memory");
    __syncthreads();
    b.target += b.n;
    if (b.wave == 0 && olane() == 0) {
        if (!b.same_xcc) { __builtin_amdgcn_fence(__ATOMIC_RELEASE, "agent"); asm volatile("s_waitcnt vmcnt(0)" ::: "memory"); }
        (void)xb_add(b.cnt, 1u);
        unsigned sp = 0; while (xb_ld(b.cnt) < b.target) { __builtin_amdgcn_s_sleep(1); if (++sp > (1u << 22)) break; }
        __builtin_amdgcn_fence(__ATOMIC_ACQUIRE, "agent");
        asm volatile("s_waitcnt vmcnt(0)" ::: "memory");
    }
    __syncthreads();
}

constexpr int N_PHASES = 20;
__global__ void __launch_bounds__(NTHREADS, 2) mk_fwd(Params P) {
    extern __shared__ __attribute__((aligned(16))) unsigned char lds_raw[];
    LAS unsigned char* lds = (LAS unsigned char*)lds_raw;
    cg::grid_group grid = cg::this_grid();
    const int lo = P.ph_lo, hi = P.ph_hi, G = gridDim.x, c = blockIdx.x;
    if (lo < 0) grid.sync();
    volatile LAS unsigned* xst = (volatile LAS unsigned*)(lds + 131072);
    const int wv = __builtin_amdgcn_readfirstlane((int)threadIdx.x >> 6);
    { const int t0_ = otid(wv); if (t0_ < 2) xst[t0_] = 0u; }
    __syncthreads();
    XcdBarrier xbar; xbar.bar = (unsigned*)P.ws; xbar.x = 0; xbar.st = xst; xbar.wave = 1;
    if (hi - lo > 1) xbar = xcd_barrier_post((unsigned*)P.ws, xst, wv);
    const bool grp_mode = (G == 256);
    GrpBar gbar; gbar.cnt = (unsigned*)P.ws + 4096 + 64 * (c & 7); gbar.target = 0u; gbar.n = (unsigned)(G >> 3); gbar.wave = wv; gbar.same_xcc = false;
    unsigned* xmask = (unsigned*)P.ws + 6144 + 64 * (c & 7);
    if (hi - lo > 1 && wv == 0 && olane() == 0) (void)__hip_atomic_fetch_or(xmask, 1u << xb_xcc_id(), __ATOMIC_RELAXED, __HIP_MEMORY_SCOPE_AGENT);
    unsigned char* ws = P.ws;
    bf16_t* hb = (bf16_t*)(ws + WS_HB); bf16_t* halt = (bf16_t*)(ws + WS_HB2);
    bf16_t* hid = (bf16_t*)(ws + WS_BIG);
    unsigned* dump = (unsigned*)(ws + 65536);
#define SSQB(i) ((float*)(ws + WS_SSQ + (size_t)(i) * 2 * MiB))
    int ph = 0, sq = 0;
    int np_cur = 16;
#define RUN(k) ((k) >= lo && (k) < hi)
#ifndef PROBE_PH
#define PROBE_PH (-1)
#endif
    unsigned long long tph_ = (PROBE_PH >= 0) ? __builtin_amdgcn_s_memrealtime() : 0ull;
#define SEAM() do { if (PROBE_PH >= 0 && ph == PROBE_PH) { const unsigned long long t1_ = __builtin_amdgcn_s_memrealtime(); while (__builtin_amdgcn_s_memrealtime() - tph_ < 4ull * (t1_ - tph_)) __builtin_amdgcn_s_sleep(8); } \
        if (RUN(ph) && RUN(ph + 1)) { if (grp_mode && ph > 0) grp_barrier(gbar); else { xcd_barrier(xbar); if (ph == 0) { const unsigned m_ = (unsigned)__builtin_amdgcn_readfirstlane((int)xb_ld(xmask)); gbar.same_xcc = (m_ != 0u) && ((m_ & (m_ - 1u)) == 0u); } } } ++ph; if (PROBE_PH >= 0) tph_ = __builtin_amdgcn_s_memrealtime(); } while (0)
    (void)np_cur;
    if (RUN(ph)) prologue(P, lds, wv);
    SEAM();
#pragma unroll 1
    for (int li = 0; li < 2; ++li) {
#pragma unroll 1
        for (int w = 0; w < 2; ++w) {
            if (RUN(ph)) {
                pg8::Gemm g{hb, (const bf16_t*)(ws + WS_WUP + (size_t)(li * 2 + w) * SZ_WUP), D, D, D, 0, 0};
                pg8::Order S; S.init(T, 2 * FF, 1, G, c); const bool quad = S.init_quad(); const bool pan = quad ? false : S.init_panel();
                if (li == 0 && w == 1) { pg8::EpiUp<32> E; E.O = hid; E.P = SSQB(0); E.have = 0; E.rsl = (LAS float*)(lds + 132096); if (quad) E.prep(S.quad_pm0, 2, wv); else if (pan && S.panel_n > 0) E.prep(S.panel_pm, 1, wv); pg8::gemm_phase(lds, g, S, E, wv, dump); }
                else { pg8::EpiUp<16> E; E.O = hid; E.P = SSQB(sq); E.have = 0; E.rsl = (LAS float*)(lds + 132096); if (quad) E.prep(S.quad_pm0, 2, wv); else if (pan && S.panel_n > 0) E.prep(S.panel_pm, 1, wv); pg8::gemm_phase(lds, g, S, E, wv, dump); }
            }
            SEAM();
            if (RUN(ph)) {
                pg8::Gemm g{hid, (const bf16_t*)(ws + WS_WDN + (size_t)(li * 2 + w) * SZ_WDN), FF, FF, FF, 0, 0};
                pg8::Order S; S.init(T, D, 1, G, c);
                pg8::EpiRes E{hb, SSQB(sq ^ 1), 0.5f}; pg8::gemm_phase(lds, g, S, E, wv, dump);
                if (w == 1) {
                    pg8::Gemm g2{(const bf16_t*)(ws + WS_PB) + (size_t)li * T * PD, (const bf16_t*)(ws + WS_WP + (size_t)li * (MiB / 2)), PD, PD, PD, 0, 0}; pg8::Order S2; S2.init(T, D, 1, G, c);
                    pg8::EpiPlain E2{(bf16_t*)(ws + WS_EXTRA), D}; pg8::gemm_phase(lds, g2, S2, E2, wv, dump);
                }
            }
            sq ^= 1;
            SEAM();
            if (w == 0) {
                if (li == 0) {
                    if (RUN(ph)) {
                        pg8::Gemm g{hb, (const bf16_t*)(ws + WS_WIN), D, D, D, 0, 0}; pg8::Order S; S.init(T, D, 1, G, c);
                        pg8::EpiWin<16> E{ws + WS_BIG, SSQB(sq)}; E.rt.rsl = (LAS float*)(lds + 132096); E.rt.have = 0; E.rt.pm_base = 0; if (S.init_quad()) pg8::rs_prep<16>(E.rt, E.P, S.quad_pm0, 2, wv);
                        pg8::gemm_phase(lds, g, S, E, wv, dump);
                    }
                    SEAM();
                    if (RUN(ph)) {
                        pg8::Gemm g{(const bf16_t*)(ws + WS_BIG), (const bf16_t*)(ws + WS_BST), A5K, 256, 256, (size_t)256 * A5K * 2, (size_t)128 * 256 * 2, SLICE};
                        pg8::Order S; S.init(CROWS, 256, NG, G, c);
                        pg8::EpiSloc E{ws + WS_BIG}; pg8::gemm_phase(lds, g, S, E, wv, dump);
                    }
                    SEAM();
                    if (RUN(ph)) s5_scan(P, wv, grp_mode);
                    SEAM();
                    if (RUN(ph)) {
                        pg8::Gemm g{(const bf16_t*)(ws + WS_BIG), (const bf16_t*)(ws + WS_BCAT), A5K, A5K, A5K, (size_t)256 * A5K * 2, (size_t)256 * A5K * 2, SLICE};
                        pg8::Order S; S.init(CROWS, 256, NG, G, c);
                        pg8::EpiY E{ws + WS_BIG, P.in[22], (bf16_t*)(ws + WS_EXTRA)}; pg8::gemm_phase(lds, g, S, E, wv, dump);
                    }
                    SEAM();
                    if (RUN(ph)) {
                        pg8::Gemm g{(const bf16_t*)(ws + WS_EXTRA), (const bf16_t*)(ws + WS_WGLU), D, D, D, 0, 0}; pg8::Order S; S.init(T, 2 * D, 1, G, c);
                        pg8::EpiGlu E{hb, SSQB(0)}; pg8::gemm_phase(lds, g, S, E, wv, dump);
                    }
                    sq ^= 1;
                    SEAM();
                } else {
                    if (RUN(ph)) {
                        { pg8::Gemm g{hb, (const bf16_t*)(ws + WS_WQKV), D, D, D, 0, 0}; pg8::Order S; S.init(T, 2 * D, 1, G, c);
                          pg8::EpiQK<16> E{halt, ws + WS_BIG, SSQB(sq)}; E.rt.rsl = (LAS float*)(lds + 132096); E.rt.have = 0; E.rt.pm_base = 0; if (S.init_quad()) pg8::rs_prep<16>(E.rt, E.P, S.quad_pm0, 2, wv);
                          pg8::gemm_phase(lds, g, S, E, wv, dump); }
                        { pg8::Gemm g{(const bf16_t*)(ws + WS_WQKV) + (size_t)2 * D * D, hb, D, D, D, 0, 0}; pg8::Order S; S.init(D, T, 1, G, c);
                          pg8::EpiVt<16> E{(bf16_t*)(ws + WS_EXTRA), SSQB(sq)}; pg8::gemm_phase(lds, g, S, E, wv, dump); }
                    }
                    SEAM();
                    if (RUN(ph)) attn_phase(P, halt, wv, grp_mode, lds);
                    SEAM();
                    if (RUN(ph)) {
                        pg8::Gemm g{halt, (const bf16_t*)(ws + WS_WO), D, D, D, 0, 0}; pg8::Order S; S.init(T, D, 1, G, c);
                        pg8::EpiRes E{hb, SSQB(sq ^ 1), 1.0f}; pg8::gemm_phase(lds, g, S, E, wv, dump);
                    }
                    sq ^= 1;
                    SEAM();
                }
            }
        }
        if (RUN(ph)) {
            pg8::Gemm g{hb, (const bf16_t*)(ws + WS_WG + (size_t)li * 2 * MiB), D, D, D, 0, 0}; pg8::Order S; S.init(T, D, 1, G, c);
            pg8::EpiPle<16> E{hb, halt, (const bf16_t*)(ws + WS_EXTRA), SSQB(sq), SSQB(sq ^ 1)}; E.rt.rsl = (LAS float*)(lds + 132096); E.rt.have = 0; E.rt.pm_base = 0; if (S.init_quad()) pg8::rs_prep<16>(E.rt, E.Pin, S.quad_pm0, 2, wv);
            pg8::gemm_phase(lds, g, S, E, wv, dump);
        }
        { bf16_t* t_ = hb; hb = halt; halt = t_; }
        sq ^= 1;
        SEAM();
    }
    if (RUN(ph)) final_norm(P, hb, SSQB(sq), wv, grp_mode);
#undef RUN
#undef SEAM
}

extern "C" void kernel_launch(void* const* d_in, const int* in_sizes, int n_in, void* d_out, int out_size, void* d_ws, size_t ws_size, hipStream_t stream) {
    static int grid = 0;
    if (grid == 0) {
        if (n_in != 27 || out_size != T * D || ws_size < WS_END) { fprintf(stderr, "kernel_launch: unexpected problem (n_in %d out %d ws %zu)\n", n_in, out_size, ws_size); grid = -1; return; }
        int dev = 0, cus = 0, per_cu = 0;
        hipGetDevice(&dev); hipDeviceGetAttribute(&cus, hipDeviceAttributeMultiprocessorCount, dev);
        hipFuncSetAttribute((const void*)mk_fwd, hipFuncAttributeMaxDynamicSharedMemorySize, LDS_BYTES);
        hipOccupancyMaxActiveBlocksPerMultiprocessor(&per_cu, (const void*)mk_fwd, NTHREADS, LDS_BYTES);
        if (per_cu < 1) per_cu = 1;
        grid = cus * per_cu;
        if (grid > 256) grid = 256;
        (void)hipGetLastError();
    }
    if (grid < 0) return;
    Params p{};
    for (int i = 0; i < 27; ++i) p.in[i] = (const float*)d_in[i];
    p.out = (float*)d_out; p.ws = (unsigned char*)d_ws;
#if MK_MULTI
    for (int k = 0; k < N_PHASES; ++k) { p.ph_lo = k; p.ph_hi = k + 1; void* args[] = {&p};
        (void)args; hipLaunchKernelGGL(mk_fwd, dim3(grid), dim3(NTHREADS), LDS_BYTES, stream, p);
        hipError_t e = hipPeekAtLastError();
        if (e != hipSuccess) { fprintf(stderr, "launch %d failed: %s\n", k, hipGetErrorString(e)); break; } }
#else
    (void)hipMemsetAsync(d_ws, 0, 32768, stream);
    p.ph_lo = 0; p.ph_hi = N_PHASES; void* args[] = {&p};
    hipError_t e = hipLaunchCooperativeKernel((const void*)mk_fwd, dim3(grid), dim3(NTHREADS), args, LDS_BYTES, stream);
    if (e != hipSuccess) fprintf(stderr, "cooperative launch failed: %s (grid %d)\n", hipGetErrorString(e), grid);
#endif
}
```

```cpp
#include <hip/hip_runtime.h>
#include <hip/hip_cooperative_groups.h>
#include <cstdio>
#include <cstdint>
namespace cg = cooperative_groups;

#ifndef MK_MULTI
#define MK_MULTI 0
#endif

#define LAS __attribute__((address_space(3)))
typedef unsigned short bf16_t;
typedef short bf16x8 __attribute__((ext_vector_type(8)));
typedef float f32x4 __attribute__((ext_vector_type(4)));
typedef float f32x2 __attribute__((ext_vector_type(2)));
typedef float f32x16 __attribute__((ext_vector_type(16)));
typedef unsigned u32x4 __attribute__((ext_vector_type(4)));
typedef unsigned u32x2 __attribute__((ext_vector_type(2)));

constexpr int NB = 16, SEQ = 2048, T = NB * SEQ, D = 1024, FF = 2816, PD = 256;
constexpr int NG = 64, NCH = 128, CROWS = NB * NCH, A5K = 384;
constexpr float EPS = 1e-6f;
constexpr float QSCALE = 0.125f * 1.4426950408889634f;
constexpr int NTHREADS = 512, NWAVES = 8;

constexpr size_t MiB = 1u << 20;
constexpr size_t WS_WUP = 1 * MiB;
constexpr size_t SZ_WUP = 11 * MiB;
constexpr size_t WS_WDN = WS_WUP + 4 * SZ_WUP;
constexpr size_t SZ_WDN = 11 * MiB / 2;
constexpr size_t WS_WG = WS_WDN + 4 * SZ_WDN;
constexpr size_t WS_WP = WS_WG + 4 * MiB;
constexpr size_t WS_WIN = WS_WP + 1 * MiB;
constexpr size_t WS_WGLU = WS_WIN + 2 * MiB;
constexpr size_t WS_WQKV = WS_WGLU + 4 * MiB;
constexpr size_t WS_WO = WS_WQKV + 6 * MiB;
constexpr size_t WS_BST = WS_WO + 2 * MiB;
constexpr size_t WS_BCAT = WS_BST + 4 * MiB;
constexpr size_t WS_AB16 = WS_BCAT + 12 * MiB;
constexpr size_t WS_SSQ = 103 * MiB;
constexpr size_t WS_HB = 107 * MiB;
constexpr size_t WS_PB = 171 * MiB;
constexpr size_t WS_BIG = 203 * MiB;
constexpr size_t WS_EXTRA = 379 * MiB;
constexpr size_t WS_HB2 = 443 * MiB;
constexpr size_t WS_END = 507 * MiB;
constexpr size_t SLICE = 22 * MiB, SLOC_OFF = 12 * MiB, VT_SLICE = 8 * MiB;

constexpr int LDS_BYTES = 131072 + 1024 + 16384;

__device__ __forceinline__ unsigned cvt_pk_bf16(float lo, float hi) { unsigned r; asm volatile("v_cvt_pk_bf16_f32 %0, %1, %2" : "=v"(r) : "v"(lo), "v"(hi)); return r; }
__device__ __forceinline__ float bf_lo(unsigned w) { return __uint_as_float(w << 16); }
__device__ __forceinline__ float bf_hi(unsigned w) { return __uint_as_float(w & 0xffff0000u); }
__device__ __forceinline__ float fast_rcp(float x) { return __builtin_amdgcn_rcpf(x); }
__device__ __forceinline__ float sigmoidf_(float x) { return fast_rcp(1.0f + __expf(-x)); }
__device__ __forceinline__ int olane() { int l; asm volatile("v_mbcnt_lo_u32_b32 %0, -1, 0\n\tv_mbcnt_hi_u32_b32 %0, -1, %0" : "=v"(l)); return l; }
__device__ __forceinline__ int otid(int wv) { return wv * 64 + olane(); }
template <int M> __device__ __forceinline__ float swz_xor(float v) { return __builtin_bit_cast(float, __builtin_amdgcn_ds_swizzle(__builtin_bit_cast(int, v), (M << 10) | 0x1F)); }
__device__ __forceinline__ float half_sum(float v) { auto rr = __builtin_amdgcn_permlane32_swap(__float_as_uint(v), __float_as_uint(v), false, false); return __uint_as_float(rr[0]) + __uint_as_float(rr[1]); }
__device__ __forceinline__ float wave_sum(float v) { v += swz_xor<1>(v); v += swz_xor<2>(v); v += swz_xor<4>(v); v += swz_xor<8>(v); v += swz_xor<16>(v); return half_sum(v); }

namespace pg8 {
constexpr int BM = 256, BK = 64, HALF = 128, HTB = HALF * BK * 2, STAGE_BYTES = 8 * HTB, NXCD = 8, WGM = 8;
__host__ __device__ __forceinline__ int lds_byte(int r, int c) { const int st = (r >> 4) * 2 + (c >> 5), rr = r & 15, cc = c & 31, ob = rr * 64 + cc * 2; return st * 1024 + (ob ^ (((ob >> 9) & 1) << 5)); }
__host__ __device__ __forceinline__ void stage_rc(int b, int& R, int& C) { const int st = b / 1024, sb = b % 1024, swz = sb ^ (((sb >> 9) & 1) << 5); R = (st >> 1) * 16 + swz / 64; C = (st & 1) * 32 + (swz % 64) / 2; }
__host__ __device__ __forceinline__ int perm32(int rho) { const int n = rho >> 4, i = rho & 15; return 8 * (i >> 2) + 4 * n + (i & 3); }

struct Unit { int pm, pn, grp; };
struct Gemm { const bf16_t* A; const bf16_t* Bt; int lda, ldb, K; size_t gsA, gsB, psA; };

struct Order {
    int nM, nN, nwg, G, c, ngrp, panel_pm, panel_pn0, panel_n;
    __device__ __forceinline__ void init(int M, int N, int ngrp_, int G_, int c_) { nM = M / BM; nN = N / BM; nwg = nM * nN; G = G_; c = c_; ngrp = ngrp_; panel_n = 0; panel_pm = 0; panel_pn0 = 0; quad_n = 0; quad_pm0 = 0; quad_r = 0; }
    __device__ __forceinline__ bool init_panel() { if (G % nM != 0 || G % NXCD != 0) return false; const int wpp = G / nM, per = (nN + wpp - 1) / wpp, v = (c % NXCD) * (G / NXCD) + c / NXCD;
        panel_pm = v / wpp; panel_pn0 = (v % wpp) * per; panel_n = (panel_pn0 + per <= nN) ? per : (nN - panel_pn0 > 0 ? nN - panel_pn0 : 0); if (panel_n == 0) panel_n = -1; return true; }
    int quad_n, quad_pm0, quad_r;
    __device__ __forceinline__ bool init_quad() { quad_n = 0; if (G != 2 * nM || (2 * nN) % 4 != 0 || G % NXCD != 0) return false; const int v = (c % NXCD) * (G / NXCD) + c / NXCD;
        quad_pm0 = 2 * (v >> 2); quad_r = v & 3; quad_n = (2 * nN) / 4; panel_n = 0; return true; }
    __device__ __forceinline__ bool next(int i, Unit& u) const {
        if (quad_n != 0) { if (i >= quad_n) return false; const int f = 4 * i + quad_r; u.grp = 0; u.pm = quad_pm0 + (f >= nN ? 1 : 0); u.pn = f >= nN ? f - nN : f; return true; }
        if (panel_n != 0) { if (i >= panel_n) return false; u.grp = 0; u.pm = panel_pm; u.pn = panel_pn0 + i; return true; }
        const long L = (long)i * G + c; if (L >= (long)nwg * ngrp) return false;
        if (ngrp > 1) { u.grp = (int)(L / nwg); const int r = (int)(L % nwg); u.pm = r / nN; u.pn = r % nN; return true; }
        u.grp = 0;
        int wgid = (int)L; { const int q = nwg / NXCD, r = nwg % NXCD, xcd = wgid % NXCD, off = wgid / NXCD; wgid = (xcd < r ? xcd * (q + 1) : r * (q + 1) + (xcd - r) * q) + off; }
        const int nig = WGM * nN, gid = wgid / nig, fm = gid * WGM, gsz = (nM - fm) < WGM ? (nM - fm) : WGM;
        u.pm = fm + ((wgid % nig) % gsz); u.pn = (wgid % nig) / gsz; return true;
    }
};

template <class Epi>
__device__ __forceinline__ void gemm_phase(LAS unsigned char* lds, const Gemm g, const Order& S, const Epi& E, int wv, unsigned* dump) {
    const int lane = olane(), wid = wv, tid = wid * 64 + lane, wr = wid >> 2, wc = wid & 3, fr = lane & 15, fq = lane >> 4;
    int nt_ = g.K / BK; asm volatile("" : "+s"(nt_)); const int nt = nt_;
    unsigned voffA, voffB;
    { int R, C; stage_rc(tid * 16, R, C); const int Rb = (R & ~31) + perm32(R & 31);
      voffA = (unsigned)(R * g.lda + C) * 2u; voffB = (unsigned)(Rb * g.ldb + C) * 2u; }
    const size_t pstepA = (size_t)64 * g.lda * 2, pstepB = (size_t)64 * g.ldb * 2;
    const size_t kstep = (size_t)(BK * 2);
    const size_t hstepA = (size_t)HALF * g.lda * 2, hstepB = (size_t)HALF * g.ldb * 2;
    const size_t tstepA = g.psA ? g.psA : 2 * hstepA, tstepB = 2 * hstepB;
    const unsigned ldsw = (unsigned)wid * 1024u;
    const int aoff = lds_byte(wr * 64 + fr, fq * 8), boff = lds_byte(wc * 32 + fr, fq * 8);
#define PG8_SA(b, h) (((b) * 2 + (h)) * HTB)
#define PG8_SB(b, h) ((4 + (b) * 2 + (h)) * HTB)
#define PG8_STAGE(bufoff, gbase, voff) do { _Pragma("unroll") for (int _i = 0; _i < 2; ++_i) \
        __builtin_amdgcn_global_load_lds((const unsigned*)((const char*)(gbase) + (size_t)_i * pstep_##voff + (voff)), (LAS unsigned*)(lds + (bufoff) + ldsw + _i * 8192), 16, 0, 0); } while (0)
#define pstep_voffA pstepA
#define pstep_voffB pstepB
#define PG8_LDA(dst, b, h) do { _Pragma("unroll") for (int m = 0; m < 4; ++m) _Pragma("unroll") for (int k = 0; k < 2; ++k) dst[m][k] = *(const LAS bf16x8*)(lds + PG8_SA(b, h) + aoff + m * 2048 + k * 1024); } while (0)
#define PG8_LDB(dst, b, h) do { _Pragma("unroll") for (int n = 0; n < 2; ++n) _Pragma("unroll") for (int k = 0; k < 2; ++k) dst[n][k] = *(const LAS bf16x8*)(lds + PG8_SB(b, h) + boff + n * 2048 + k * 1024); } while (0)
#define PG8_MMA(ai, bj, At, Bt) do { __builtin_amdgcn_s_setprio(1); _Pragma("unroll") for (int m = 0; m < 4; ++m) _Pragma("unroll") for (int n = 0; n < 2; ++n) _Pragma("unroll") for (int k = 0; k < 2; ++k) \
        acc[ai][bj][m][n] = __builtin_amdgcn_mfma_f32_16x16x32_bf16(Bt[n][k], At[m][k], acc[ai][bj][m][n], 0, 0, 0); __builtin_amdgcn_s_setprio(0); } while (0)
#define PG8_WAIT_V(n) asm volatile("s_waitcnt vmcnt(" #n ")" ::: "memory")
#define PG8_WAIT_L(n) asm volatile("s_waitcnt lgkmcnt(" #n ")" ::: "memory")
#define PG8_BAR __builtin_amdgcn_s_barrier()
#define PG8_SCHED __builtin_amdgcn_sched_barrier(0)
    Unit cur, nxt; int ui = 0;
    if (!S.next(0, cur)) return;
    f32x4 acc[2][2][4][2];
#pragma unroll
    for (int a = 0; a < 2; ++a)
#pragma unroll
        for (int b = 0; b < 2; ++b)
#pragma unroll
            for (int m = 0; m < 4; ++m)
#pragma unroll
                for (int n = 0; n < 2; ++n) acc[a][b][m][n] = (f32x4){0.f, 0.f, 0.f, 0.f};
    bf16x8 At[4][2], B0[2][2], B1[2][2];
    const char* cA = (const char*)g.A + (size_t)cur.grp * g.gsA + (size_t)cur.pm * tstepA;
    const char* cB = (const char*)g.Bt + (size_t)cur.grp * g.gsB + (size_t)cur.pn * tstepB;
    PG8_STAGE(PG8_SB(0, 0), cB, voffB); PG8_STAGE(PG8_SB(0, 1), cB + hstepB, voffB); PG8_STAGE(PG8_SA(0, 0), cA, voffA); PG8_STAGE(PG8_SA(0, 1), cA + hstepA, voffA);
    if (wr == 1) PG8_BAR;
    PG8_WAIT_V(2); PG8_BAR;
    PG8_STAGE(PG8_SB(1, 0), cB + kstep, voffB); PG8_STAGE(PG8_SA(1, 0), cA + kstep, voffA); PG8_STAGE(PG8_SB(1, 1), cB + hstepB + kstep, voffB);
    PG8_WAIT_V(6); PG8_BAR;
    for (;;) {
        const bool has_next = S.next(ui + 1, nxt);
        const char* nA = has_next ? (const char*)g.A + (size_t)nxt.grp * g.gsA + (size_t)nxt.pm * tstepA : cA;
        const char* nB = has_next ? (const char*)g.Bt + (size_t)nxt.grp * g.gsB + (size_t)nxt.pn * tstepB : cB;
#define PG8_KPAIR(WV_FIRST) do { \
            const bool last = (t == nt - 2); \
            const char* a1 = cA + (size_t)(t + 1) * kstep; \
            const char* a2 = last ? nA : cA + (size_t)(t + 2) * kstep; const char* b2 = last ? nB : cB + (size_t)(t + 2) * kstep; \
            const char* a3 = a2 + kstep; const char* b3 = b2 + kstep; \
            PG8_LDB(B0, 0, 0); PG8_LDB(B1, 0, 1); PG8_SCHED; PG8_LDA(At, 0, 0); PG8_STAGE(PG8_SA(1, 1), a1 + hstepA, voffA); \
            WV_FIRST; PG8_WAIT_L(0); PG8_BAR; PG8_MMA(0, 0, At, B0); PG8_MMA(0, 1, At, B1); PG8_BAR; PG8_SCHED; \
            PG8_LDA(At, 0, 1); PG8_STAGE(PG8_SB(0, 0), b2, voffB); PG8_STAGE(PG8_SB(0, 1), b2 + hstepB, voffB); PG8_STAGE(PG8_SA(0, 0), a2, voffA); \
            WV_FIRST; PG8_WAIT_L(0); PG8_BAR; PG8_MMA(1, 0, At, B0); PG8_MMA(1, 1, At, B1); PG8_BAR; PG8_SCHED; \
            PG8_LDB(B0, 1, 0); PG8_LDB(B1, 1, 1); PG8_SCHED; PG8_LDA(At, 1, 0); PG8_STAGE(PG8_SA(0, 1), a2 + hstepA, voffA); \
            PG8_WAIT_V(8); PG8_WAIT_L(0); PG8_BAR; PG8_MMA(0, 0, At, B0); PG8_MMA(0, 1, At, B1); PG8_BAR; PG8_SCHED; \
            PG8_LDA(At, 1, 1); PG8_STAGE(PG8_SB(1, 0), b3, voffB); PG8_STAGE(PG8_SB(1, 1), b3 + hstepB, voffB); PG8_STAGE(PG8_SA(1, 0), a3, voffA); \
            PG8_WAIT_V(8); PG8_WAIT_L(0); PG8_BAR; PG8_MMA(1, 0, At, B0); PG8_MMA(1, 1, At, B1); PG8_BAR; PG8_SCHED; } while (0)
        for (int t = 0; t < nt; t += 2) PG8_KPAIR(PG8_WAIT_V(8));
#undef PG8_KPAIR
        if (wr == 0) PG8_BAR;
        { const int l_ = olane();
          E(acc, cur, wr, wc, l_ & 15, l_ >> 4); }
        if (!has_next) break;
#pragma unroll
        for (int a = 0; a < 2; ++a)
#pragma unroll
            for (int b = 0; b < 2; ++b)
#pragma unroll
                for (int m = 0; m < 4; ++m)
#pragma unroll
                    for (int n = 0; n < 2; ++n) acc[a][b][m][n] = (f32x4){0.f, 0.f, 0.f, 0.f};
        cur = nxt; cA = nA; cB = nB; ++ui;
        if (wr == 1) PG8_BAR;
    }
    PG8_WAIT_V(0);
    PG8_BAR;
#undef PG8_SA
#undef PG8_SB
#undef PG8_STAGE
#undef pstep_voffA
#undef pstep_voffB
#undef PG8_LDA
#undef PG8_LDB
#undef PG8_MMA
#undef PG8_WAIT_V
#undef PG8_WAIT_L
#undef PG8_BAR
#undef PG8_SCHED
}

typedef f32x4 Acc[2][2][4][2];
__device__ __forceinline__ float xsum_fq(float s) {
    s += __builtin_bit_cast(float, __builtin_amdgcn_ds_swizzle(__builtin_bit_cast(int, s), 0x401F));
    auto rr = __builtin_amdgcn_permlane32_swap(__float_as_uint(s), __float_as_uint(s), false, false);
    return __uint_as_float(rr[0]) + __uint_as_float(rr[1]);
}

template <int NP> __device__ __forceinline__ void load_rstd(const float* P, int row0, int fq, float (&rs)[2][4]) {
    const float* P2 = P + (size_t)2 * MiB / 4;
#pragma unroll
    for (int ai = 0; ai < 2; ++ai)
#pragma unroll
        for (int m = 0; m < 4; ++m) {
            const f32x4* p = (const f32x4*)(P + (size_t)(row0 + 128 * ai + 16 * m) * 16) + fq;
            f32x4 v = p[0]; float s = (v[0] + v[1]) + (v[2] + v[3]);
            if (NP == 32) { const f32x4 w = *((const f32x4*)(P2 + (size_t)(row0 + 128 * ai + 16 * m) * 16) + fq); s += (w[0] + w[1]) + (w[2] + w[3]); }
            s = xsum_fq(s);
            rs[ai][m] = rsqrtf(s * (1.0f / D) + EPS);
        }
}
__device__ __forceinline__ u32x4 pack8(f32x4 a, f32x4 b) { u32x4 w; w.x = cvt_pk_bf16(a[0], a[1]); w.y = cvt_pk_bf16(a[2], a[3]); w.z = cvt_pk_bf16(b[0], b[1]); w.w = cvt_pk_bf16(b[2], b[3]); return w; }

struct RsTab { LAS float* rsl; int have, pm_base; };
template <int NP> __device__ __forceinline__ void rs_prep(RsTab& t, const float* P, int pm, int npan, int wv) { const int l = olane(); t.pm_base = pm; t.have = 1;
    for (int p = 0; p < npan; ++p) { float rs[2][4]; load_rstd<NP>(P, (pm + p) * BM + (wv >> 2) * 64 + (l & 15), l >> 4, rs);
        if ((l >> 4) == 0) { LAS f32x4* d = (LAS f32x4*)(t.rsl + ((p * 8 + wv) * 16 + (l & 15)) * 8); d[0] = (f32x4){rs[0][0], rs[0][1], rs[0][2], rs[0][3]}; d[1] = (f32x4){rs[1][0], rs[1][1], rs[1][2], rs[1][3]}; } } }
template <int NP> __device__ __forceinline__ void rs_fetch(const RsTab& t, const float* P, const Unit& u, int wr, int wc, int fr, int fq, float (&rl)[2][4]) {
    if (t.have) { const LAS f32x4* d = (const LAS f32x4*)(t.rsl + (((u.pm - t.pm_base) * 8 + wr * 4 + wc) * 16 + fr) * 8); const f32x4 a = d[0], b = d[1];
#pragma unroll
        for (int m = 0; m < 4; ++m) { rl[0][m] = a[m]; rl[1][m] = b[m]; } }
    else load_rstd<NP>(P, u.pm * BM + wr * 64 + fr, fq, rl);
}
__device__ __forceinline__ f32x2 pk_gate(f32x2 q, f32x2 g, float c) { f32x2 t = g * c; t.x = __builtin_amdgcn_exp2f(t.x); t.y = __builtin_amdgcn_exp2f(t.y); f32x2 d = t + 1.0f; d.x = __builtin_amdgcn_rcpf(d.x); d.y = __builtin_amdgcn_rcpf(d.y); return q * d; }
template <int NPIN> struct EpiUp { static constexpr int NST = 8;
    bf16_t* O; const float* P; LAS float* rsl; int have, pm_base;
    __device__ __forceinline__ void prep(int pm, int npan, int wv) { const int l = olane(); pm_base = pm; have = 1;
        for (int p = 0; p < npan; ++p) { float rs[2][4]; load_rstd<NPIN>(P, (pm + p) * BM + (wv >> 2) * 64 + (l & 15), l >> 4, rs);
            if ((l >> 4) == 0) { LAS f32x4* d = (LAS f32x4*)(rsl + ((p * 8 + wv) * 16 + (l & 15)) * 8); d[0] = (f32x4){rs[0][0], rs[0][1], rs[0][2], rs[0][3]}; d[1] = (f32x4){rs[1][0], rs[1][1], rs[1][2], rs[1][3]}; } } }
    __device__ __forceinline__ void operator()(const Acc& acc, const Unit& u, int wr, int wc, int fr, int fq) const {
        const int row0 = u.pm * BM + wr * 64 + fr; float rl[2][4];
        if (have) { const LAS f32x4* d = (const LAS f32x4*)(rsl + (((u.pm - pm_base) * 8 + wr * 4 + wc) * 16 + fr) * 8); const f32x4 a = d[0], b = d[1];
#pragma unroll
            for (int m = 0; m < 4; ++m) { rl[0][m] = a[m]; rl[1][m] = b[m]; } }
        else load_rstd<NPIN>(P, row0, fq, rl);
        const int col0 = u.pn * 128 + wc * 32 + 8 * fq;
#pragma unroll
        for (int ai = 0; ai < 2; ++ai)
#pragma unroll
            for (int m = 0; m < 4; ++m) { const float r = rl[ai][m], c1 = r * -1.4426950408889634f, r2 = r * r; f32x4 o[2];
#pragma unroll
                for (int n = 0; n < 2; ++n)
#pragma unroll
                    for (int c = 0; c < 4; c += 2) { const f32x2 a = {acc[ai][0][m][n][c], acc[ai][0][m][n][c + 1]}, b = {acc[ai][1][m][n][c], acc[ai][1][m][n][c + 1]};
                        f32x2 t = a * c1; t.x = __builtin_amdgcn_exp2f(t.x); t.y = __builtin_amdgcn_exp2f(t.y);
                        f32x2 d = t + 1.0f; d.x = __builtin_amdgcn_rcpf(d.x); d.y = __builtin_amdgcn_rcpf(d.y);
                        const f32x2 v = ((a * b) * r2) * d; o[n][c] = v.x; o[n][c + 1] = v.y; }
                *(u32x4*)(O + (size_t)(row0 + ai * HALF + m * 16) * FF + col0) = pack8(o[0], o[1]); }
    }
};
__device__ __forceinline__ void unpack8(u32x4 w, f32x4& a, f32x4& b) { a[0] = bf_lo(w.x); a[1] = bf_hi(w.x); a[2] = bf_lo(w.y); a[3] = bf_hi(w.y); b[0] = bf_lo(w.z); b[1] = bf_hi(w.z); b[2] = bf_lo(w.w); b[3] = bf_hi(w.w); }
__device__ __forceinline__ float sumsq8(f32x4 h0, f32x4 h1) { return (h0[0] * h0[0] + h0[1] * h0[1]) + (h0[2] * h0[2] + h0[3] * h0[3]) + (h1[0] * h1[0] + h1[1] * h1[1]) + (h1[2] * h1[2] + h1[3] * h1[3]); }
struct EpiRes { static constexpr int NST = 24;
    bf16_t* hb; float* Pout; float scale;
    __device__ __forceinline__ void operator()(const Acc& acc, const Unit& u, int wr, int wc, int fr, int fq) const {
        const int row0 = u.pm * BM + wr * 64 + fr;
        bf16_t* base = hb + (size_t)row0 * D + u.pn * BM + wc * 32 + 8 * fq;
        u32x4 hw[2][4][2];
#pragma unroll
        for (int ai = 0; ai < 2; ++ai)
#pragma unroll
            for (int m = 0; m < 4; ++m)
#pragma unroll
                for (int bj = 0; bj < 2; ++bj) hw[ai][m][bj] = *(const u32x4*)(base + (size_t)(ai * HALF + m * 16) * D + bj * HALF);
#pragma unroll
        for (int ai = 0; ai < 2; ++ai)
#pragma unroll
            for (int m = 0; m < 4; ++m) { float ss = 0.f;
#pragma unroll
                for (int bj = 0; bj < 2; ++bj) { f32x4 h0, h1; unpack8(hw[ai][m][bj], h0, h1);
                    h0 = h0 + acc[ai][bj][m][0] * scale; h1 = h1 + acc[ai][bj][m][1] * scale;
                    *(u32x4*)(base + (size_t)(ai * HALF + m * 16) * D + bj * HALF) = pack8(h0, h1); ss += sumsq8(h0, h1); }
                ss = xsum_fq(ss);
                if (fq == 0) Pout[(size_t)(row0 + ai * HALF + m * 16) * 16 + u.pn * 4 + wc] = ss; }
    }
};
struct EpiGlu { static constexpr int NST = 16;
    bf16_t* hb; float* Pout;
    __device__ __forceinline__ void operator()(const Acc& acc, const Unit& u, int wr, int wc, int fr, int fq) const {
        const int row0 = u.pm * BM + wr * 64 + fr;
        bf16_t* base = hb + (size_t)row0 * D + u.pn * 128 + wc * 32 + 8 * fq;
        u32x4 hw[2][4];
#pragma unroll
        for (int ai = 0; ai < 2; ++ai)
#pragma unroll
            for (int m = 0; m < 4; ++m) hw[ai][m] = *(const u32x4*)(base + (size_t)(ai * HALF + m * 16) * D);
#pragma unroll
        for (int ai = 0; ai < 2; ++ai)
#pragma unroll
            for (int m = 0; m < 4; ++m) { f32x4 h0, h1; unpack8(hw[ai][m], h0, h1);
#pragma unroll
                for (int c = 0; c < 4; c += 2) {
                    const f32x2 v0 = pk_gate((f32x2){acc[ai][0][m][0][c], acc[ai][0][m][0][c + 1]}, (f32x2){acc[ai][1][m][0][c], acc[ai][1][m][0][c + 1]}, -1.4426950408889634f);
                    const f32x2 v1 = pk_gate((f32x2){acc[ai][0][m][1][c], acc[ai][0][m][1][c + 1]}, (f32x2){acc[ai][1][m][1][c], acc[ai][1][m][1][c + 1]}, -1.4426950408889634f);
                    h0[c] += v0.x; h0[c + 1] += v0.y; h1[c] += v1.x; h1[c + 1] += v1.y; }
                *(u32x4*)(base + (size_t)(ai * HALF + m * 16) * D) = pack8(h0, h1);
                float ss = xsum_fq(sumsq8(h0, h1));
                if (fq == 0) (Pout + (size_t)(u.pn >> 2) * (2 * MiB / 4))[(size_t)(row0 + ai * HALF + m * 16) * 16 + (u.pn & 3) * 4 + wc] = ss; }
    }
};
template <int NPIN> struct EpiPle { static constexpr int NST = 24;
    const bf16_t* hin; bf16_t* hout; const bf16_t* pp; const float* Pin; float* Pout; RsTab rt;
    __device__ __forceinline__ void operator()(const Acc& acc, const Unit& u, int wr, int wc, int fr, int fq) const {
        const int row0 = u.pm * BM + wr * 64 + fr; float rs[2][4]; rs_fetch<NPIN>(rt, Pin, u, wr, wc, fr, fq, rs);
#pragma unroll
        for (int ai = 0; ai < 2; ++ai)
#pragma unroll
            for (int m = 0; m < 4; ++m) { const int row = row0 + ai * HALF + m * 16; float ss = 0.f; const float r = rs[ai][m];
#pragma unroll
                for (int bj = 0; bj < 2; ++bj) { const size_t off = (size_t)row * D + u.pn * BM + bj * HALF + wc * 32 + 8 * fq;
                    f32x4 h0, h1, p0, p1; unpack8(*(const u32x4*)(hin + off), h0, h1); unpack8(*(const u32x4*)(pp + off), p0, p1);
#pragma unroll
                    for (int c = 0; c < 4; c += 2) { const float c1 = r * -1.4426950408889634f;
                        const f32x2 v0 = pk_gate((f32x2){p0[c], p0[c + 1]}, (f32x2){acc[ai][bj][m][0][c], acc[ai][bj][m][0][c + 1]}, c1);
                        const f32x2 v1 = pk_gate((f32x2){p1[c], p1[c + 1]}, (f32x2){acc[ai][bj][m][1][c], acc[ai][bj][m][1][c + 1]}, c1);
                        h0[c] += v0.x; h0[c + 1] += v0.y; h1[c] += v1.x; h1[c + 1] += v1.y; }
                    *(u32x4*)(hout + off) = pack8(h0, h1); ss += sumsq8(h0, h1); }
                ss = xsum_fq(ss);
                if (fq == 0) Pout[(size_t)row * 16 + u.pn * 4 + wc] = ss; }
    }
};
struct EpiPlain { static constexpr int NST = 16;
    bf16_t* O; int ldc;
    __device__ __forceinline__ void operator()(const Acc& acc, const Unit& u, int wr, int wc, int fr, int fq) const {
        const int row0 = u.pm * BM + wr * 64 + fr;
#pragma unroll
        for (int ai = 0; ai < 2; ++ai)
#pragma unroll
            for (int m = 0; m < 4; ++m)
#pragma unroll
                for (int bj = 0; bj < 2; ++bj)
                    *(u32x4*)(O + (size_t)(row0 + ai * HALF + m * 16) * ldc + u.pn * BM + bj * HALF + wc * 32 + 8 * fq) = pack8(acc[ai][bj][m][0], acc[ai][bj][m][1]);
    }
};
template <int NPIN> struct EpiWin { static constexpr int NST = 16;
    unsigned char* big; const float* P; RsTab rt;
    __device__ __forceinline__ void operator()(const Acc& acc, const Unit& u, int wr, int wc, int fr, int fq) const {
        const int row0 = u.pm * BM + wr * 64 + fr; float rs[2][4]; rs_fetch<NPIN>(rt, P, u, wr, wc, fr, fq, rs);
#pragma unroll
        for (int ai = 0; ai < 2; ++ai)
#pragma unroll
            for (int m = 0; m < 4; ++m) { const int tok = row0 + ai * HALF + m * 16; const float r = rs[ai][m];
#pragma unroll
                for (int bj = 0; bj < 2; ++bj) { const int ch = u.pn * BM + bj * HALF + wc * 32 + 8 * fq; const int gI = ch >> 4, hi0 = ch & 15;
                    *(u32x4*)((bf16_t*)(big + (size_t)(tok >> 12) * SLICE) + (size_t)(gI * 256 + ((tok >> 4) & 255)) * A5K + (tok & 15) * 16 + hi0) = pack8(acc[ai][bj][m][0] * r, acc[ai][bj][m][1] * r); } }
    }
};
struct EpiSloc { static constexpr int NST = 16;
    unsigned char* big;
    __device__ __forceinline__ void operator()(const Acc& acc, const Unit& u, int wr, int wc, int fr, int fq) const {
        const int rl0 = wr * 64 + fr; float* S = (float*)(big + (size_t)u.pm * SLICE + SLOC_OFF);
#pragma unroll
        for (int ai = 0; ai < 2; ++ai)
#pragma unroll
            for (int m = 0; m < 4; ++m) { float* o = S + (size_t)(u.grp * 256 + rl0 + ai * HALF + m * 16) * 128 + wc * 32 + 8 * fq;
                *(f32x4*)o = acc[ai][0][m][0]; *(f32x4*)(o + 4) = acc[ai][0][m][1]; }
    }
};
struct EpiY { static constexpr int NST = 16;
    const unsigned char* big; const float* dsk; bf16_t* Z;
    __device__ __forceinline__ void operator()(const Acc& acc, const Unit& u, int wr, int wc, int fr, int fq) const {
        const int rl0 = wr * 64 + fr; const int gI = u.grp; const bf16_t* A5 = (const bf16_t*)(big + (size_t)u.pm * SLICE);
#pragma unroll
        for (int bj = 0; bj < 2; ++bj) { const int n0 = bj * HALF + wc * 32 + 8 * fq, tl = n0 >> 4, ho0 = n0 & 15;
            const f32x4 d0 = *(const f32x4*)(dsk + gI * 16 + ho0), d1 = *(const f32x4*)(dsk + gI * 16 + ho0 + 4);
#pragma unroll
            for (int ai = 0; ai < 2; ++ai)
#pragma unroll
                for (int m = 0; m < 4; ++m) { const int rl = rl0 + ai * HALF + m * 16, R = u.pm * BM + rl;
                    const u32x4 uw = *(const u32x4*)(A5 + (size_t)(gI * 256 + rl) * A5K + n0);
                    f32x4 y0 = acc[ai][bj][m][0], y1 = acc[ai][bj][m][1];
                    y0[0] += d0[0] * bf_lo(uw.x); y0[1] += d0[1] * bf_hi(uw.x); y0[2] += d0[2] * bf_lo(uw.y); y0[3] += d0[3] * bf_hi(uw.y);
                    y1[0] += d1[0] * bf_lo(uw.z); y1[1] += d1[1] * bf_hi(uw.z); y1[2] += d1[2] * bf_lo(uw.w); y1[3] += d1[3] * bf_hi(uw.w);
#pragma unroll
                    for (int c = 0; c < 4; c += 2) {
                        const f32x2 a = {y0[c], y0[c + 1]}, b = {y1[c], y1[c + 1]};
                        const f32x2 va = pk_gate(a, a * (a * a * 0.044715f + 1.0f), -2.3022081983f), vb = pk_gate(b, b * (b * b * 0.044715f + 1.0f), -2.3022081983f);
                        y0[c] = va.x; y0[c + 1] = va.y; y1[c] = vb.x; y1[c + 1] = vb.y; }
                    *(u32x4*)(Z + (size_t)(R * 16 + tl) * D + gI * 16 + ho0) = pack8(y0, y1);
                    asm volatile("" ::: "memory"); } }
    }
};
template <int NPIN> struct EpiQK { static constexpr int NST = 16;
    bf16_t* Q; unsigned char* big; const float* P; RsTab rt;
    __device__ __forceinline__ void operator()(const Acc& acc, const Unit& u, int wr, int wc, int fr, int fq) const {
        const int row0 = u.pm * BM + wr * 64 + fr; float rs[2][4]; rs_fetch<NPIN>(rt, P, u, wr, wc, fr, fq, rs);
        bf16_t* base = (u.pn < 4) ? Q : (bf16_t*)(big + (size_t)(u.pm >> 4) * SLICE) - (size_t)(u.pm >> 4) * 4096 * D; const float sc = (u.pn < 4) ? QSCALE : 1.0f;
#pragma unroll
        for (int ai = 0; ai < 2; ++ai)
#pragma unroll
            for (int m = 0; m < 4; ++m) { const float r = rs[ai][m] * sc;
#pragma unroll
                for (int bj = 0; bj < 2; ++bj)
                    *(u32x4*)(base + (size_t)(row0 + ai * HALF + m * 16) * D + (u.pn & 3) * BM + bj * HALF + wc * 32 + 8 * fq) = pack8(acc[ai][bj][m][0] * r, acc[ai][bj][m][1] * r); }
    }
};
template <int NPIN> struct EpiVt { static constexpr int NST = 16;
    bf16_t* Vt; const float* P;
    __device__ __forceinline__ void operator()(const Acc& acc, const Unit& u, int wr, int wc, int fr, int fq) const {
        const int lane = fq * 16 + fr; const int row0 = u.pm * BM + wr * 64 + fr;
        float myrs; { const int tok = u.pn * BM + (lane >> 5) * HALF + wc * 32 + (lane & 31); const f32x4* p = (const f32x4*)(P + (size_t)tok * NPIN); float s = 0.f;
#pragma unroll
            for (int j = 0; j < NPIN / 4; ++j) { f32x4 v = p[j]; s += (v[0] + v[1]) + (v[2] + v[3]); }
            myrs = rsqrtf(s * (1.0f / D) + EPS); }
        float rsv[2][8];
#pragma unroll
        for (int bj = 0; bj < 2; ++bj)
#pragma unroll
            for (int e = 0; e < 8; ++e) rsv[bj][e] = __builtin_bit_cast(float, __builtin_amdgcn_ds_bpermute((bj * 32 + 8 * fq + e) << 2, __builtin_bit_cast(int, myrs)));
#pragma unroll
        for (int ai = 0; ai < 2; ++ai)
#pragma unroll
            for (int m = 0; m < 4; ++m)
#pragma unroll
                for (int bj = 0; bj < 2; ++bj) { f32x4 a = acc[ai][bj][m][0], b = acc[ai][bj][m][1];
#pragma unroll
                    for (int c = 0; c < 4; ++c) { a[c] *= rsv[bj][c]; b[c] *= rsv[bj][4 + c]; }
                    *(u32x4*)((bf16_t*)((unsigned char*)Vt + (size_t)(u.pn >> 4) * VT_SLICE) + (size_t)(row0 + ai * HALF + m * 16) * 4096 + (u.pn & 15) * BM + bj * HALF + wc * 32 + 8 * fq) = pack8(a, b); }
    }
};
}

struct Params {
    const float* in[27]; float* out; unsigned char* ws; int ph_lo, ph_hi;
};

__device__ __forceinline__ void transpose_item(const float* W, int K, int N, const float* gain, bf16_t* WT, int mode, int off, LAS float* scr, int item, int lane) {
    const int nblk = N / 32, kb = item / nblk, nb = item % nblk, k0 = 64 * kb, n0 = 32 * nb;
    float wv[32];
#pragma unroll
    for (int i = 0; i < 32; ++i) wv[i] = W[(size_t)(k0 + 2 * i + (lane >> 5)) * N + n0 + (lane & 31)];
    if (gain) {
#pragma unroll
        for (int i = 0; i < 32; ++i) wv[i] *= gain[k0 + 2 * i + (lane >> 5)]; }
#pragma unroll
    for (int i = 0; i < 32; ++i) scr[(2 * i + (lane >> 5)) * 33 + (lane & 31)] = wv[i];
    asm volatile("s_waitcnt lgkmcnt(0)" ::: "memory");
    const int c = lane & 7;
    int d0;
    if (mode == 0) d0 = n0;
    else if (mode == 1) d0 = (n0 / 128) * 256 + off + (n0 % 128);
    else { const int half = n0 / 1024, cc = n0 % 1024; d0 = (cc / 128) * 256 + half * 128 + (cc % 128); }
#pragma unroll
    for (int j = 0; j < 4; ++j) { const int n = (lane >> 3) + 8 * j; const LAS float* s = scr + (8 * c) * 33 + n;
        u32x4 o; o.x = cvt_pk_bf16(s[0 * 33], s[1 * 33]); o.y = cvt_pk_bf16(s[2 * 33], s[3 * 33]); o.z = cvt_pk_bf16(s[4 * 33], s[5 * 33]); o.w = cvt_pk_bf16(s[6 * 33], s[7 * 33]);
        *(u32x4*)(WT + (size_t)(d0 + n) * K + k0 + 8 * c) = o; }
    asm volatile("s_waitcnt lgkmcnt(0)" ::: "memory");
}

__device__ __forceinline__ void weight_item(const Params& P, int it, LAS float* scr, int lane) {
    unsigned char* ws = P.ws;
    constexpr int IU = (D / 64) * (FF / 32);
    if (it < 12 * IU) {
        const int j = it / IU, r = it % IU, li = j / 6, rr = j % 6, w = rr / 3, t = rr % 3;
        if (t < 2) { const float* src = P.in[(w ? 8 : 3) + t] + (size_t)li * D * FF; const float* gain = P.in[w ? 7 : 2] + li * D;
            transpose_item(src, D, FF, gain, (bf16_t*)(ws + WS_WUP + (size_t)(li * 2 + w) * SZ_WUP), 1, t * 128, scr, r, lane); }
        else { const float* src = P.in[w ? 10 : 5] + (size_t)li * FF * D;
            transpose_item(src, FF, D, nullptr, (bf16_t*)(ws + WS_WDN + (size_t)(li * 2 + w) * SZ_WDN), 0, 0, scr, r, lane); }
        return;
    }
    it -= 12 * IU;
    if (it < 1280) { const int li = it / 640, r2 = it % 640;
        if (r2 < 512) transpose_item(P.in[13] + (size_t)li * D * D, D, D, P.in[11] + li * D, (bf16_t*)(ws + WS_WG + (size_t)li * 2 * MiB), 0, 0, scr, r2, lane);
        else transpose_item(P.in[12] + (size_t)li * PD * D, PD, D, nullptr, (bf16_t*)(ws + WS_WP + (size_t)li * (MiB / 2)), 0, 0, scr, r2 - 512, lane);
        return; }
    it -= 1280;
    if (it < 512) { transpose_item(P.in[14], D, D, P.in[6], (bf16_t*)(ws + WS_WIN), 0, 0, scr, it, lane); return; }
    if (it < 1536) { transpose_item(P.in[23], D, 2 * D, nullptr, (bf16_t*)(ws + WS_WGLU), 2, 0, scr, it - 512, lane); return; }
    if (it < 3072) { transpose_item(P.in[24], D, 3 * D, P.in[6] + D, (bf16_t*)(ws + WS_WQKV), 0, 0, scr, it - 1536, lane); return; }
    transpose_item(P.in[25], D, D, nullptr, (bf16_t*)(ws + WS_WO), 0, 0, scr, it - 3072, lane);
}
constexpr int N_WITEMS = 12 * 1408 + 1280 + 3584;

__device__ __forceinline__ void s5_setup_group(const Params& P, int g, int part, int nparts, LAS float* lds, int wv) {
    LAS float* PW = lds;
    LAS float* BB = PW + 17 * 128;
    LAS float* CC = BB + 2048;
    LAS float* KT = CC + 2048;
    const int tid = otid(wv);
    bf16_t* Bst = (bf16_t*)(P.ws + WS_BST) + (size_t)g * 128 * 256;
    bf16_t* Bcat = (bf16_t*)(P.ws + WS_BCAT) + (size_t)g * 256 * A5K;
    float* ab16 = (float*)(P.ws + WS_AB16);
    if (tid < 64) {
        const int p = tid;
        double lre = (double)P.in[15][g * 64 + p]; if (lre > -1e-4) lre = -1e-4;
        const double lim = (double)P.in[16][g * 64 + p];
        const double dt = exp((double)P.in[17][g]);
        const double mag = exp(lre * dt);
        double x = lim * dt; const double twopi = 6.283185307179586476925; x -= twopi * rint(x / twopi);
        const double y = x * (1.0 / 16.0), y2 = y * y;
        double sn = y * (1.0 - y2 / 6.0 * (1.0 - y2 / 20.0 * (1.0 - y2 / 42.0 * (1.0 - y2 / 72.0 * (1.0 - y2 / 110.0 * (1.0 - y2 / 156.0))))));
        double cs = 1.0 - y2 / 2.0 * (1.0 - y2 / 12.0 * (1.0 - y2 / 30.0 * (1.0 - y2 / 56.0 * (1.0 - y2 / 90.0 * (1.0 - y2 / 132.0 * (1.0 - y2 / 182.0))))));
#pragma unroll
        for (int k = 0; k < 4; ++k) { const double s2 = 2.0 * sn * cs, c2 = cs * cs - sn * sn; sn = s2; cs = c2; }
        const double ar = mag * cs, ai = mag * sn;
        const double nr = ar - 1.0, ni = ai, den = lre * lre + lim * lim;
        const double fr = (nr * lre + ni * lim) / den, fi = (ni * lre - nr * lim) / den;
        double pr = 1.0, pi = 0.0;
        for (int tau = 0; tau <= 16; ++tau) { PW[(tau * 64 + p) * 2] = (float)pr; PW[(tau * 64 + p) * 2 + 1] = (float)pi; const double npr = pr * ar - pi * ai, npi = pr * ai + pi * ar; pr = npr; pi = npi; }
        if (part == 0) { ab16[(g * 64 + p) * 2] = PW[(16 * 64 + p) * 2]; ab16[(g * 64 + p) * 2 + 1] = PW[(16 * 64 + p) * 2 + 1]; }
        for (int hi = 0; hi < 16; ++hi) { const double br = (double)P.in[18][(size_t)(g * 64 + p) * 16 + hi], bi = (double)P.in[19][(size_t)(g * 64 + p) * 16 + hi];
            BB[(p * 16 + hi) * 2] = (float)(fr * br - fi * bi); BB[(p * 16 + hi) * 2 + 1] = (float)(fr * bi + fi * br); }
    }
    for (int i = tid; i < 1024; i += NTHREADS) { CC[i * 2] = P.in[20][(size_t)g * 1024 + i]; CC[i * 2 + 1] = P.in[21][(size_t)g * 1024 + i]; }
    __syncthreads();
    if (tid < 256) { const int tau = tid >> 4, ho = tid & 15; float a[16];
#pragma unroll
        for (int hi = 0; hi < 16; ++hi) a[hi] = 0.f;
        for (int p = 0; p < 64; ++p) { const float cr = CC[(ho * 64 + p) * 2], ci = CC[(ho * 64 + p) * 2 + 1], pr = PW[(tau * 64 + p) * 2], pi = PW[(tau * 64 + p) * 2 + 1];
            const float wr = cr * pr - ci * pi, wi = cr * pi + ci * pr;
#pragma unroll
            for (int hi = 0; hi < 16; ++hi) a[hi] += wr * BB[(p * 16 + hi) * 2] - wi * BB[(p * 16 + hi) * 2 + 1]; }
#pragma unroll
        for (int hi = 0; hi < 16; ++hi) KT[(tau * 16 + ho) * 16 + hi] = a[hi]; }
    __syncthreads();
    const int bst_rows = 128 / nparts, bcat_rows = 256 / nparts;
    for (int idx = tid; idx < bst_rows * 32; idx += NTHREADS) { const int n = part * bst_rows + (idx >> 5), k0 = (idx & 31) * 8, j = k0 >> 4, hi0 = k0 & 15; float v[8];
        { const int p = n >> 1, ri = n & 1; const float pr = PW[((15 - j) * 64 + p) * 2], pi = PW[((15 - j) * 64 + p) * 2 + 1];
#pragma unroll
            for (int e = 0; e < 8; ++e) { const float br = BB[(p * 16 + hi0 + e) * 2], bi = BB[(p * 16 + hi0 + e) * 2 + 1]; v[e] = ri ? (pr * bi + pi * br) : (pr * br - pi * bi); } }
        u32x4 o; o.x = cvt_pk_bf16(v[0], v[1]); o.y = cvt_pk_bf16(v[2], v[3]); o.z = cvt_pk_bf16(v[4], v[5]); o.w = cvt_pk_bf16(v[6], v[7]);
        *(u32x4*)(Bst + (size_t)n * 256 + k0) = o; }
    for (int idx = tid; idx < bcat_rows * 48; idx += NTHREADS) { const int n = part * bcat_rows + idx / 48, k0 = (idx % 48) * 8, tl = n >> 4, ho = n & 15; float v[8];
        if (k0 < 256) { const int j = k0 >> 4, hi0 = k0 & 15;
#pragma unroll
            for (int e = 0; e < 8; ++e) v[e] = (tl >= j) ? KT[((tl - j) * 16 + ho) * 16 + hi0 + e] : 0.f; }
        else { const int kk0 = k0 - 256;
#pragma unroll
            for (int e = 0; e < 8; ++e) { const int kk = kk0 + e, p = kk >> 1, ri = kk & 1; const float cr = CC[(ho * 64 + p) * 2], ci = CC[(ho * 64 + p) * 2 + 1], pr = PW[((tl + 1) * 64 + p) * 2], pi = PW[((tl + 1) * 64 + p) * 2 + 1];
                v[e] = ri ? -(cr * pi + ci * pr) : (cr * pr - ci * pi); } }
        u32x4 o; o.x = cvt_pk_bf16(v[0], v[1]); o.y = cvt_pk_bf16(v[2], v[3]); o.z = cvt_pk_bf16(v[4], v[5]); o.w = cvt_pk_bf16(v[6], v[7]);
        *(u32x4*)(Bcat + (size_t)n * A5K + k0) = o; }
    __syncthreads();
}

__device__ __forceinline__ void prologue(const Params& P, LAS unsigned char* lds, int wv) {
    const int tid = otid(wv), lane = tid & 63, wave = wv, G = gridDim.x;
    { const int nparts = (G >= 4 * NG) ? 4 : 1; for (int j = blockIdx.x; j < NG * nparts; j += G) s5_setup_group(P, j / nparts, j % nparts, nparts, (LAS float*)lds, wv); }
    const int gw = blockIdx.x * NWAVES + wave, NGW = G * NWAVES;
    LAS float* scr = (LAS float*)(lds + wave * 16384);
    for (int it = gw; it < N_WITEMS; it += NGW) weight_item(P, it, scr, lane);
    const float* x = P.in[0]; bf16_t* hb = (bf16_t*)(P.ws + WS_HB); float* ssq = (float*)(P.ws + WS_SSQ);
    for (int m = gw; m < T; m += 2 * NGW) {
        const int m2 = m + NGW; const bool has2 = m2 < T;
        const f32x4* xr = (const f32x4*)(x + (size_t)m * D) + lane; const f32x4* xr2 = (const f32x4*)(x + (size_t)(has2 ? m2 : m) * D) + lane; f32x4 v[4], v2[4]; float s = 0.f, s2 = 0.f;
#pragma unroll
        for (int j = 0; j < 4; ++j) { v[j] = xr[64 * j]; v2[j] = xr2[64 * j]; }
#pragma unroll
        for (int j = 0; j < 4; ++j) { s += (v[j][0] * v[j][0] + v[j][1] * v[j][1]) + (v[j][2] * v[j][2] + v[j][3] * v[j][3]); s2 += (v2[j][0] * v2[j][0] + v2[j][1] * v2[j][1]) + (v2[j][2] * v2[j][2] + v2[j][3] * v2[j][3]); }
        s = wave_sum(s); s2 = wave_sum(s2);
        u32x2* o = (u32x2*)(hb + (size_t)m * D) + lane;
#pragma unroll
        for (int j = 0; j < 4; ++j) { u32x2 w; w.x = cvt_pk_bf16(v[j][0], v[j][1]); w.y = cvt_pk_bf16(v[j][2], v[j][3]); o[64 * j] = w; }
        if (lane < 16) ssq[(size_t)m * 16 + lane] = (lane == 0) ? s : 0.f;
        if (has2) { u32x2* o2 = (u32x2*)(hb + (size_t)m2 * D) + lane;
#pragma unroll
            for (int j = 0; j < 4; ++j) { u32x2 w; w.x = cvt_pk_bf16(v2[j][0], v2[j][1]); w.y = cvt_pk_bf16(v2[j][2], v2[j][3]); o2[64 * j] = w; }
            if (lane < 16) ssq[(size_t)m2 * 16 + lane] = (lane == 0) ? s2 : 0.f; }
    }
    const f32x4* pp = (const f32x4*)P.in[1]; u32x2* pb = (u32x2*)(P.ws + WS_PB);
    const size_t n4 = (size_t)2 * T * PD / 4;
    const size_t st = (size_t)G * NTHREADS;
    for (size_t i = (size_t)blockIdx.x * NTHREADS + tid; i < n4; i += 4 * st) { f32x4 v[4];
#pragma unroll
        for (int j = 0; j < 4; ++j) if (i + j * st < n4) v[j] = pp[i + j * st];
#pragma unroll
        for (int j = 0; j < 4; ++j) if (i + j * st < n4) { u32x2 w; w.x = cvt_pk_bf16(v[j][0], v[j][1]); w.y = cvt_pk_bf16(v[j][2], v[j][3]); pb[i + j * st] = w; } }
}

__device__ __forceinline__ void s5_scan(const Params& P, int wv, bool grp_mode) {
    const int lane = olane(), wave = wv;
    const float* ab16 = (const float*)(P.ws + WS_AB16);
    const int pstart = grp_mode ? (wave < 4 ? ((int)(blockIdx.x & 7) * 128 + (int)(blockIdx.x >> 3) * 4 + wave) : NB * NG) : (int)(blockIdx.x + gridDim.x * wave);
    const int pstep = grp_mode ? NB * NG : (int)(gridDim.x * NWAVES);
    for (int pair = pstart; pair < NB * NG; pair += pstep) {
        const int b = pair / NG, g = pair % NG, p = lane;
        const float ar = ab16[(g * 64 + p) * 2], ai = ab16[(g * 64 + p) * 2 + 1];
        float sr = 0.f, si = 0.f;
        unsigned char* slice = P.ws + WS_BIG + (size_t)(b >> 1) * SLICE; const int rl0 = (b & 1) * NCH;
        const f32x2* src = (const f32x2*)((const float*)(slice + SLOC_OFF) + (size_t)(g * 256 + rl0) * 128) + p;
        unsigned* dst = (unsigned*)((bf16_t*)slice + (size_t)(g * 256 + rl0) * A5K + 256) + p;
        for (int c0 = 0; c0 < NCH; c0 += 32) {
            f32x2 v[32];
#pragma unroll
            for (int j = 0; j < 32; ++j) v[j] = src[(size_t)(c0 + j) * 64];
#pragma unroll
            for (int j = 0; j < 32; ++j) { dst[(size_t)(c0 + j) * (A5K / 2)] = cvt_pk_bf16(sr, si);
                const float nr = ar * sr - ai * si + v[j][0], ni = ar * si + ai * sr + v[j][1]; sr = nr; si = ni; }
        }
    }
}

__device__ __forceinline__ float shfl32(float v, int hi) { auto rr = __builtin_amdgcn_permlane32_swap(__float_as_uint(v), __float_as_uint(v), false, false); return hi ? __uint_as_float(rr[0]) : __uint_as_float(rr[1]); }
__device__ __forceinline__ void attn_phase(const Params& P, bf16_t* QO, int wv, bool grp_mode, LAS unsigned char* lds) {
    const int lane = olane(), wave = wv, r32 = lane & 31, hi = lane >> 5;
    LAS unsigned char* wl = lds + wave * 10240;
    const bf16_t* Q = QO; bf16_t* O = QO;
    const int NGW = grp_mode ? 256 : (int)(gridDim.x * NWAVES);
    const int ustart = grp_mode ? ((int)(blockIdx.x >> 3) * NWAVES + wave) : (int)(blockIdx.x + gridDim.x * wave);
    const int uend = grp_mode ? 2048 : NB * 16 * 64, ubase = grp_mode ? (int)(blockIdx.x & 7) * 2048 : 0;
    u32x4 qqN[4], kqN[4], vqN[4];
#define ATT_UNIT_LOAD(UL) do { const int un_ = ubase + (UL); const int bh_ = un_ >> 6, qb_ = un_ & 63, b_ = bh_ >> 4, h_ = bh_ & 15; \
        const bf16_t* Kn_ = (const bf16_t*)(P.ws + WS_BIG + (size_t)(b_ >> 1) * SLICE) + (size_t)(b_ & 1) * SEQ * D; \
        const bf16_t* Vn_ = (const bf16_t*)(P.ws + WS_EXTRA + (size_t)(b_ >> 1) * VT_SLICE) + (size_t)(b_ & 1) * SEQ; \
        _Pragma("unroll") for (int j = 0; j < 4; ++j) { \
            qqN[j] = *(const u32x4*)(Q + ((size_t)b_ * SEQ + qb_ * 32 + (lane >> 3) + 8 * j) * D + h_ * 64 + (lane & 7) * 8); \
            kqN[j] = *(const u32x4*)(Kn_ + (size_t)(qb_ * 32 + (lane >> 3) + 8 * j) * D + h_ * 64 + (lane & 7) * 8); \
            vqN[j] = *(const u32x4*)(Vn_ + (size_t)(h_ * 64 + (lane >> 2) + 16 * j) * 4096 + qb_ * 32 + (lane & 3) * 8); } } while (0)
    if (ustart < uend) ATT_UNIT_LOAD(ustart);
    for (int ul = ustart; ul < uend; ul += NGW) {
        const int unit = ubase + ul;
        const int bh = unit >> 6, qb = unit & 63, b = bh >> 4, h = bh & 15, q0 = qb * 32; const size_t tokbase = (size_t)b * SEQ;
        const bf16_t* Kk = (const bf16_t*)(P.ws + WS_BIG + (size_t)(b >> 1) * SLICE) + (size_t)(b & 1) * SEQ * D;
        const bf16_t* Vt = (const bf16_t*)(P.ws + WS_EXTRA + (size_t)(b >> 1) * VT_SLICE) + (size_t)(b & 1) * SEQ;
        bf16x8 qf[4];
        {
#pragma unroll
            for (int j = 0; j < 4; ++j) *(LAS u32x4*)(wl + ((lane >> 3) + 8 * j) * 144 + (lane & 7) * 16) = qqN[j];
#pragma unroll
            for (int d0 = 0; d0 < 4; ++d0) qf[d0] = *(const LAS bf16x8*)(wl + r32 * 144 + d0 * 32 + hi * 16);
        }
        f32x16 o0 = {}, o1 = {}; float carry = 1.0f;
        u32x4 kq[4], vq[4];
#define ATT_LOAD(KT) do { const int kv0_ = (KT) * 32; \
            _Pragma("unroll") for (int j = 0; j < 4; ++j) { kq[j] = *(const u32x4*)(Kk + (size_t)(kv0_ + (lane >> 3) + 8 * j) * D + h * 64 + (lane & 7) * 8); \
                                                            vq[j] = *(const u32x4*)(Vt + (size_t)(h * 64 + (lane >> 2) + 16 * j) * 4096 + kv0_ + (lane & 3) * 8); } } while (0)
#pragma unroll
        for (int j = 0; j < 4; ++j) { kq[j] = kqN[j]; vq[j] = vqN[j]; }
        { const int uln = (ul + NGW < uend) ? ul + NGW : ul; ATT_UNIT_LOAD(uln); }
        for (int kt = qb; kt >= 0; --kt) {
            bf16x8 kf[4]; u32x2 vlo[2][2], vhi[2][2];
#pragma unroll
            for (int j = 0; j < 4; ++j) { *(LAS u32x4*)(wl + ((lane >> 3) + 8 * j) * 144 + (lane & 7) * 16) = kq[j]; *(LAS u32x4*)(wl + 4608 + ((lane >> 2) + 16 * j) * 80 + (lane & 3) * 16) = vq[j]; }
            { const int ktn = kt > 0 ? kt - 1 : 0; ATT_LOAD(ktn); }
#pragma unroll
            for (int d0 = 0; d0 < 4; ++d0) kf[d0] = *(const LAS bf16x8*)(wl + r32 * 144 + d0 * 32 + hi * 16);
#pragma unroll
            for (int db = 0; db < 2; ++db)
#pragma unroll
                for (int kk = 0; kk < 2; ++kk) { const LAS unsigned char* vp = wl + 4608 + (db * 32 + r32) * 80 + kk * 32 + hi * 8; vlo[db][kk] = *(const LAS u32x2*)vp; vhi[db][kk] = *(const LAS u32x2*)(vp + 16); }
            f32x16 s = {};
#pragma unroll
            for (int d0 = 0; d0 < 4; ++d0) s = __builtin_amdgcn_mfma_f32_32x32x16_bf16(kf[d0], qf[d0], s, 0, 0, 0);
            float kp[16], sg[16];
#pragma unroll
            for (int r = 0; r < 16; ++r) { const float t = __builtin_amdgcn_exp2f(fminf(s[r], 80.0f)); const float rr = fast_rcp(1.0f + t); kp[r] = rr; sg[r] = t * rr; }
            if (kt == qb) {
#pragma unroll
                for (int r = 0; r < 16; ++r) { const int i = (r & 3) + 8 * (r >> 2) + 4 * hi; if (i >= r32) { kp[r] = 1.0f; sg[r] = 0.f; } }
            }
            float ex[16], tot[4];
#pragma unroll
            for (int bq = 0; bq < 4; ++bq) { ex[4 * bq + 3] = 1.0f; ex[4 * bq + 2] = kp[4 * bq + 3]; ex[4 * bq + 1] = ex[4 * bq + 2] * kp[4 * bq + 2]; ex[4 * bq] = ex[4 * bq + 1] * kp[4 * bq + 1]; tot[bq] = ex[4 * bq] * kp[4 * bq]; }
            float pt[4], Y[4];
#pragma unroll
            for (int bq = 0; bq < 4; ++bq) pt[bq] = shfl32(tot[bq], hi);
            Y[3] = carry; Y[2] = Y[3] * (tot[3] * pt[3]); Y[1] = Y[2] * (tot[2] * pt[2]); Y[0] = Y[1] * (tot[1] * pt[1]); carry = Y[0] * (tot[0] * pt[0]);
            float att[16];
#pragma unroll
            for (int bq = 0; bq < 4; ++bq) { const float X = hi ? Y[bq] : Y[bq] * pt[bq];
#pragma unroll
                for (int w = 0; w < 4; ++w) att[4 * bq + w] = sg[4 * bq + w] * (X * ex[4 * bq + w]); }
            bf16x8 pb[2];
#pragma unroll
            for (int kk = 0; kk < 2; ++kk) { u32x4 w; w.x = cvt_pk_bf16(att[8 * kk], att[8 * kk + 1]); w.y = cvt_pk_bf16(att[8 * kk + 2], att[8 * kk + 3]); w.z = cvt_pk_bf16(att[8 * kk + 4], att[8 * kk + 5]); w.w = cvt_pk_bf16(att[8 * kk + 6], att[8 * kk + 7]);
                pb[kk] = __builtin_bit_cast(bf16x8, w); }
#pragma unroll
            for (int kk = 0; kk < 2; ++kk) {
                u32x4 a0; a0.x = vlo[0][kk].x; a0.y = vlo[0][kk].y; a0.z = vhi[0][kk].x; a0.w = vhi[0][kk].y;
                u32x4 a1; a1.x = vlo[1][kk].x; a1.y = vlo[1][kk].y; a1.z = vhi[1][kk].x; a1.w = vhi[1][kk].y;
                o0 = __builtin_amdgcn_mfma_f32_32x32x16_bf16(__builtin_bit_cast(bf16x8, a0), pb[kk], o0, 0, 0, 0);
                o1 = __builtin_amdgcn_mfma_f32_32x32x16_bf16(__builtin_bit_cast(bf16x8, a1), pb[kk], o1, 0, 0, 0);
            }
            if (!__any(carry > 1e-16f)) break;
        }
#pragma unroll
        for (int rq = 0; rq < 4; ++rq) {
            u32x2 w0; w0.x = cvt_pk_bf16(o0[4 * rq], o0[4 * rq + 1]); w0.y = cvt_pk_bf16(o0[4 * rq + 2], o0[4 * rq + 3]); *(LAS u32x2*)(wl + r32 * 144 + (8 * rq + 4 * hi) * 2) = w0;
            u32x2 w1; w1.x = cvt_pk_bf16(o1[4 * rq], o1[4 * rq + 1]); w1.y = cvt_pk_bf16(o1[4 * rq + 2], o1[4 * rq + 3]); *(LAS u32x2*)(wl + r32 * 144 + 64 + (8 * rq + 4 * hi) * 2) = w1;
        }
#pragma unroll
        for (int j = 0; j < 4; ++j) { const u32x4 v = *(const LAS u32x4*)(wl + ((lane >> 3) + 8 * j) * 144 + (lane & 7) * 16);
            *(u32x4*)(O + (tokbase + q0 + (lane >> 3) + 8 * j) * D + h * 64 + (lane & 7) * 8) = v; }
    }
}

__device__ __forceinline__ void final_norm(const Params& P, const bf16_t* hb, const float* ssq, int wv, bool grp_mode) {
    const int lane = olane(), wave = wv;
    const int gw = grp_mode ? ((int)(blockIdx.x & 7) * 4096 + (int)(blockIdx.x >> 3) * NWAVES + wave) : (int)(blockIdx.x * NWAVES + wave), NGW = grp_mode ? 256 : (int)(gridDim.x * NWAVES);
    const int mend = grp_mode ? ((int)(blockIdx.x & 7) + 1) * 4096 : T;
    f32x4 gv[4];
#pragma unroll
    for (int j = 0; j < 2; ++j) { gv[2 * j] = *(const f32x4*)(P.in[26] + j * 512 + 8 * lane); gv[2 * j + 1] = *(const f32x4*)(P.in[26] + j * 512 + 8 * lane + 4); }
    for (int m = gw; m < mend; m += NGW) {
        float s = (lane < 16) ? ssq[(size_t)m * 16 + lane] : 0.f;
        const u32x4 w0 = *(const u32x4*)(hb + (size_t)m * D + 8 * lane), w1 = *(const u32x4*)(hb + (size_t)m * D + 512 + 8 * lane);
        s = wave_sum(s);
        const float rs = rsqrtf(s * (1.0f / D) + EPS);
        f32x4 a, b; float* o = P.out + (size_t)m * D + 8 * lane;
        pg8::unpack8(w0, a, b); *(f32x4*)o = a * rs * gv[0]; *(f32x4*)(o + 4) = b * rs * gv[1];
        pg8::unpack8(w1, a, b); *(f32x4*)(o + 512) = a * rs * gv[2]; *(f32x4*)(o + 516) = b * rs * gv[3];
    }
}


#define XB_TMO      128
#define XB_XCNT(j)  (256  + 64 * (j))
#define XB_XSUB(j)  (1280 + 64 * (j))
#define XB_XGEN(j)  (2304 + 64 * (j))
#define XB_TOP      3328
#define XB_TOPGEN   3392
#define XCD_BAR_WORDS 3456
#define XB_SPIN_CAP (1u << 18)
__device__ __forceinline__ unsigned xb_ld(unsigned* p)              { return __hip_atomic_load(p, __ATOMIC_RELAXED, __HIP_MEMORY_SCOPE_AGENT); }
__device__ __forceinline__ unsigned xb_add(unsigned* p, unsigned v) { return __hip_atomic_fetch_add(p, v, __ATOMIC_RELAXED, __HIP_MEMORY_SCOPE_AGENT); }
__device__ __forceinline__ unsigned xb_xcc_id() { return (unsigned)__builtin_amdgcn_s_getreg((3 << 11) | 20) & 0xFu; }
#define XB_SPIN(cond, bar) do { unsigned _sp = 0; while (cond) { __builtin_amdgcn_s_sleep(1); \
    if ((++_sp & 255u) == 0u) { if (xb_ld(&(bar)[XB_TMO])) break; if (_sp > XB_SPIN_CAP) { atomicAdd(&(bar)[XB_TMO], 1u); break; } } } } while (0)
struct XcdBarrier { unsigned* bar; unsigned x; volatile LAS unsigned* st; int wave; };
__device__ __forceinline__ bool xb_leader(const XcdBarrier& b) { return b.wave == 0 && olane() == 0; }
__device__ __forceinline__ XcdBarrier xcd_barrier_post(unsigned* bar, volatile LAS unsigned* st, int wv) {
    XcdBarrier b; b.bar = bar; b.x = xb_xcc_id(); b.st = st; b.wave = wv;
    if (xb_leader(b)) (void)xb_add(&bar[XB_XCNT(b.x)], 1u);
    return b;
}
__device__ __forceinline__ void xcd_barrier_complete(unsigned* bar, unsigned x, unsigned& nloc, unsigned& nx) {
    const unsigned G = gridDim.x * gridDim.y * gridDim.z;
    unsigned sum, cnt, mine, sp = 0u;
    for (;;) {
        sum = 0u; cnt = 0u; mine = 0u;
#pragma unroll
        for (unsigned j = 0; j < 16; ++j) { const unsigned c = xb_ld(&bar[XB_XCNT(j)]); sum += c; cnt += (c > 0u) ? 1u : 0u; mine = (j == x) ? c : mine; }
        if (sum == G) break;
        __builtin_amdgcn_s_sleep(1);
        if ((++sp & 255u) == 0u) { if (xb_ld(&bar[XB_TMO])) break; if (sp > XB_SPIN_CAP) { atomicAdd(&bar[XB_TMO], 1u); break; } }
    }
    nloc = mine > 0u ? mine : 1u; nx = cnt > 0u ? cnt : 1u;
}
__device__ __forceinline__ void xcd_barrier(const XcdBarrier& b) {
    asm volatile("s_waitcnt vmcnt(0)" ::: "memory");
    __syncthreads();
    if (xb_leader(b)) {
        unsigned* bar = b.bar;
        __builtin_amdgcn_s_waitcnt(0);
        unsigned nloc = b.st[0], nx = b.st[1];
        if (nloc == 0u) { xcd_barrier_complete(bar, b.x, nloc, nx); b.st[0] = nloc; b.st[1] = nx; }
        const unsigned old = xb_add(&bar[XB_XSUB(b.x)], 1u);
        const unsigned gen = old / nloc;
        if (old + 1u == (gen + 1u) * nloc) {
            __builtin_amdgcn_fence(__ATOMIC_RELEASE, "agent");
            asm volatile("s_waitcnt vmcnt(0)" ::: "memory");
            const unsigned og = xb_add(&bar[XB_TOP], 1u);
            const unsigned tg = og / nx;
            if (og + 1u == (tg + 1u) * nx) xb_add(&bar[XB_TOPGEN], 1u);
            else XB_SPIN(xb_ld(&bar[XB_TOPGEN]) == tg, bar);
            __builtin_amdgcn_fence(__ATOMIC_ACQUIRE, "agent");
            xb_add(&bar[XB_XGEN(b.x)], 1u);
            asm volatile("s_waitcnt vmcnt(0)" ::: "memory");
        } else {
            XB_SPIN(xb_ld(&bar[XB_XGEN(b.x)]) == gen, bar);
            __builtin_amdgcn_fence(__ATOMIC_ACQUIRE, "agent");
            asm volatile("s_waitcnt vmcnt(0)" ::: "memory");
        }
    }
    __syncthreads();
}

struct GrpBar { unsigned* cnt; unsigned target, n; int wave; bool same_xcc; };
__device__ __forceinline__ void grp_barrier(GrpBar& b) {
    asm volatile("s_waitcnt vmcnt(0)" ::: "memory");
    __syncthreads();
    b.target += b.n;
    if (b.wave == 0 && olane() == 0) {
        if (!b.same_xcc) { __builtin_amdgcn_fence(__ATOMIC_RELEASE, "agent"); asm volatile("s_waitcnt vmcnt(0)" ::: "memory"); }
        (void)xb_add(b.cnt, 1u);
        unsigned sp = 0; while (xb_ld(b.cnt) < b.target) { __builtin_amdgcn_s_sleep(1); if (++sp > (1u << 22)) break; }
        __builtin_amdgcn_fence(__ATOMIC_ACQUIRE, "agent");
        asm volatile("s_waitcnt vmcnt(0)" ::: "memory");
    }
    __syncthreads();
}

constexpr int N_PHASES = 20;
__global__ void __launch_bounds__(NTHREADS, 2) mk_fwd(Params P) {
    extern __shared__ __attribute__((aligned(16))) unsigned char lds_raw[];
    LAS unsigned char* lds = (LAS unsigned char*)lds_raw;
    cg::grid_group grid = cg::this_grid();
    const int lo = P.ph_lo, hi = P.ph_hi, G = gridDim.x, c = blockIdx.x;
    if (lo < 0) grid.sync();
    volatile LAS unsigned* xst = (volatile LAS unsigned*)(lds + 131072);
    const int wv = __builtin_amdgcn_readfirstlane((int)threadIdx.x >> 6);
    { const int t0_ = otid(wv); if (t0_ < 2) xst[t0_] = 0u; }
    __syncthreads();
    XcdBarrier xbar; xbar.bar = (unsigned*)P.ws; xbar.x = 0; xbar.st = xst; xbar.wave = 1;
    if (hi - lo > 1) xbar = xcd_barrier_post((unsigned*)P.ws, xst, wv);
    const bool grp_mode = (G == 256);
    GrpBar gbar; gbar.cnt = (unsigned*)P.ws + 4096 + 64 * (c & 7); gbar.target = 0u; gbar.n = (unsigned)(G >> 3); gbar.wave = wv; gbar.same_xcc = false;
    unsigned* xmask = (unsigned*)P.ws + 6144 + 64 * (c & 7);
    if (hi - lo > 1 && wv == 0 && olane() == 0) (void)__hip_atomic_fetch_or(xmask, 1u << xb_xcc_id(), __ATOMIC_RELAXED, __HIP_MEMORY_SCOPE_AGENT);
    unsigned char* ws = P.ws;
    bf16_t* hb = (bf16_t*)(ws + WS_HB); bf16_t* halt = (bf16_t*)(ws + WS_HB2);
    bf16_t* hid = (bf16_t*)(ws + WS_BIG);
    unsigned* dump = (unsigned*)(ws + 65536);
#define SSQB(i) ((float*)(ws + WS_SSQ + (size_t)(i) * 2 * MiB))
    int ph = 0, sq = 0;
    int np_cur = 16;
#define RUN(k) ((k) >= lo && (k) < hi)
#ifndef PROBE_PH
#define PROBE_PH (-1)
#endif
    unsigned long long tph_ = (PROBE_PH >= 0) ? __builtin_amdgcn_s_memrealtime() : 0ull;
#define SEAM() do { if (PROBE_PH >= 0 && ph == PROBE_PH) { const unsigned long long t1_ = __builtin_amdgcn_s_memrealtime(); while (__builtin_amdgcn_s_memrealtime() - tph_ < 4ull * (t1_ - tph_)) __builtin_amdgcn_s_sleep(8); } \
        if (RUN(ph) && RUN(ph + 1)) { if (grp_mode && ph > 0) grp_barrier(gbar); else { xcd_barrier(xbar); if (ph == 0) { const unsigned m_ = (unsigned)__builtin_amdgcn_readfirstlane((int)xb_ld(xmask)); gbar.same_xcc = (m_ != 0u) && ((m_ & (m_ - 1u)) == 0u); } } } ++ph; if (PROBE_PH >= 0) tph_ = __builtin_amdgcn_s_memrealtime(); } while (0)
    (void)np_cur;
    if (RUN(ph)) prologue(P, lds, wv);
    SEAM();
#pragma unroll 1
    for (int li = 0; li < 2; ++li) {
#pragma unroll 1
        for (int w = 0; w < 2; ++w) {
            if (RUN(ph)) {
                pg8::Gemm g{hb, (const bf16_t*)(ws + WS_WUP + (size_t)(li * 2 + w) * SZ_WUP), D, D, D, 0, 0};
                pg8::Order S; S.init(T, 2 * FF, 1, G, c); const bool quad = S.init_quad(); const bool pan = quad ? false : S.init_panel();
                if (li == 0 && w == 1) { pg8::EpiUp<32> E; E.O = hid; E.P = SSQB(0); E.have = 0; E.rsl = (LAS float*)(lds + 132096); if (quad) E.prep(S.quad_pm0, 2, wv); else if (pan && S.panel_n > 0) E.prep(S.panel_pm, 1, wv); pg8::gemm_phase(lds, g, S, E, wv, dump); }
                else { pg8::EpiUp<16> E; E.O = hid; E.P = SSQB(sq); E.have = 0; E.rsl = (LAS float*)(lds + 132096); if (quad) E.prep(S.quad_pm0, 2, wv); else if (pan && S.panel_n > 0) E.prep(S.panel_pm, 1, wv); pg8::gemm_phase(lds, g, S, E, wv, dump); }
            }
            SEAM();
            if (RUN(ph)) {
                pg8::Gemm g{hid, (const bf16_t*)(ws + WS_WDN + (size_t)(li * 2 + w) * SZ_WDN), FF, FF, FF, 0, 0};
                pg8::Order S; S.init(T, D, 1, G, c);
                pg8::EpiRes E{hb, SSQB(sq ^ 1), 0.5f}; pg8::gemm_phase(lds, g, S, E, wv, dump);
                if (w == 1) {
                    pg8::Gemm g2{(const bf16_t*)(ws + WS_PB) + (size_t)li * T * PD, (const bf16_t*)(ws + WS_WP + (size_t)li * (MiB / 2)), PD, PD, PD, 0, 0}; pg8::Order S2; S2.init(T, D, 1, G, c);
                    pg8::EpiPlain E2{(bf16_t*)(ws + WS_EXTRA), D}; pg8::gemm_phase(lds, g2, S2, E2, wv, dump);
                }
            }
            sq ^= 1;
            SEAM();
            if (w == 0) {
                if (li == 0) {
                    if (RUN(ph)) {
                        pg8::Gemm g{hb, (const bf16_t*)(ws + WS_WIN), D, D, D, 0, 0}; pg8::Order S; S.init(T, D, 1, G, c);
                        pg8::EpiWin<16> E{ws + WS_BIG, SSQB(sq)}; E.rt.rsl = (LAS float*)(lds + 132096); E.rt.have = 0; E.rt.pm_base = 0; if (S.init_quad()) pg8::rs_prep<16>(E.rt, E.P, S.quad_pm0, 2, wv);
                        pg8::gemm_phase(lds, g, S, E, wv, dump);
                    }
                    SEAM();
                    if (RUN(ph)) {
                        pg8::Gemm g{(const bf16_t*)(ws + WS_BIG), (const bf16_t*)(ws + WS_BST), A5K, 256, 256, (size_t)256 * A5K * 2, (size_t)128 * 256 * 2, SLICE};
                        pg8::Order S; S.init(CROWS, 256, NG, G, c);
                        pg8::EpiSloc E{ws + WS_BIG}; pg8::gemm_phase(lds, g, S, E, wv, dump);
                    }
                    SEAM();
                    if (RUN(ph)) s5_scan(P, wv, grp_mode);
                    SEAM();
                    if (RUN(ph)) {
                        pg8::Gemm g{(const bf16_t*)(ws + WS_BIG), (const bf16_t*)(ws + WS_BCAT), A5K, A5K, A5K, (size_t)256 * A5K * 2, (size_t)256 * A5K * 2, SLICE};
                        pg8::Order S; S.init(CROWS, 256, NG, G, c);
                        pg8::EpiY E{ws + WS_BIG, P.in[22], (bf16_t*)(ws + WS_EXTRA)}; pg8::gemm_phase(lds, g, S, E, wv, dump);
                    }
                    SEAM();
                    if (RUN(ph)) {
                        pg8::Gemm g{(const bf16_t*)(ws + WS_EXTRA), (const bf16_t*)(ws + WS_WGLU), D, D, D, 0, 0}; pg8::Order S; S.init(T, 2 * D, 1, G, c);
                        pg8::EpiGlu E{hb, SSQB(0)}; pg8::gemm_phase(lds, g, S, E, wv, dump);
                    }
                    sq ^= 1;
                    SEAM();
                } else {
                    if (RUN(ph)) {
                        { pg8::Gemm g{hb, (const bf16_t*)(ws + WS_WQKV), D, D, D, 0, 0}; pg8::Order S; S.init(T, 2 * D, 1, G, c);
                          pg8::EpiQK<16> E{halt, ws + WS_BIG, SSQB(sq)}; E.rt.rsl = (LAS float*)(lds + 132096); E.rt.have = 0; E.rt.pm_base = 0; if (S.init_quad()) pg8::rs_prep<16>(E.rt, E.P, S.quad_pm0, 2, wv);
                          pg8::gemm_phase(lds, g, S, E, wv, dump); }
                        { pg8::Gemm g{(const bf16_t*)(ws + WS_WQKV) + (size_t)2 * D * D, hb, D, D, D, 0, 0}; pg8::Order S; S.init(D, T, 1, G, c);
                          pg8::EpiVt<16> E{(bf16_t*)(ws + WS_EXTRA), SSQB(sq)}; pg8::gemm_phase(lds, g, S, E, wv, dump); }
                    }
                    SEAM();
                    if (RUN(ph)) attn_phase(P, halt, wv, grp_mode, lds);
                    SEAM();
                    if (RUN(ph)) {
                        pg8::Gemm g{halt, (const bf16_t*)(ws + WS_WO), D, D, D, 0, 0}; pg8::Order S; S.init(T, D, 1, G, c);
                        pg8::EpiRes E{hb, SSQB(sq ^ 1), 1.0f}; pg8::gemm_phase(lds, g, S, E, wv, dump);
                    }
                    sq ^= 1;
                    SEAM();
                }
            }
        }
        if (RUN(ph)) {
            pg8::Gemm g{hb, (const bf16_t*)(ws + WS_WG + (size_t)li * 2 * MiB), D, D, D, 0, 0}; pg8::Order S; S.init(T, D, 1, G, c);
            pg8::EpiPle<16> E{hb, halt, (const bf16_t*)(ws + WS_EXTRA), SSQB(sq), SSQB(sq ^ 1)}; E.rt.rsl = (LAS float*)(lds + 132096); E.rt.have = 0; E.rt.pm_base = 0; if (S.init_quad()) pg8::rs_prep<16>(E.rt, E.Pin, S.quad_pm0, 2, wv);
            pg8::gemm_phase(lds, g, S, E, wv, dump);
        }
        { bf16_t* t_ = hb; hb = halt; halt = t_; }
        sq ^= 1;
        SEAM();
    }
    if (RUN(ph)) final_norm(P, hb, SSQB(sq), wv, grp_mode);
#undef RUN
#undef SEAM
}

extern "C" void kernel_launch(void* const* d_in, const int* in_sizes, int n_in, void* d_out, int out_size, void* d_ws, size_t ws_size, hipStream_t stream) {
    static int grid = 0;
    if (grid == 0) {
        if (n_in != 27 || out_size != T * D || ws_size < WS_END) { fprintf(stderr, "kernel_launch: unexpected problem (n_in %d out %d ws %zu)\n", n_in, out_size, ws_size); grid = -1; return; }
        int dev = 0, cus = 0, per_cu = 0;
        hipGetDevice(&dev); hipDeviceGetAttribute(&cus, hipDeviceAttributeMultiprocessorCount, dev);
        hipFuncSetAttribute((const void*)mk_fwd, hipFuncAttributeMaxDynamicSharedMemorySize, LDS_BYTES);
        hipOccupancyMaxActiveBlocksPerMultiprocessor(&per_cu, (const void*)mk_fwd, NTHREADS, LDS_BYTES);
        if (per_cu < 1) per_cu = 1;
        grid = cus * per_cu;
        if (grid > 256) grid = 256;
        (void)hipGetLastError();
    }
    if (grid < 0) return;
    Params p{};
    for (int i = 0; i < 27; ++i) p.in[i] = (const float*)d_in[i];
    p.out = (float*)d_out; p.ws = (unsigned char*)d_ws;
#if MK_MULTI
    for (int k = 0; k < N_PHASES; ++k) { p.ph_lo = k; p.ph_hi = k + 1; void* args[] = {&p};
        (void)args; hipLaunchKernelGGL(mk_fwd, dim3(grid), dim3(NTHREADS), LDS_BYTES, stream, p);
        hipError_t e = hipPeekAtLastError();
        if (e != hipSuccess) { fprintf(stderr, "launch %d failed: %s\n", k, hipGetErrorString(e)); break; } }
#else
    (void)hipMemsetAsync(d_ws, 0, 32768, stream);
    p.ph_lo = 0; p.ph_hi = N_PHASES; void* args[] = {&p};
    hipError_t e = hipLaunchCooperativeKernel((const void*)mk_fwd, dim3(grid), dim3(NTHREADS), args, LDS_BYTES, stream);
    if (e != hipSuccess) fprintf(stderr, "cooperative launch failed: %s (grid %d)\n", hipGetErrorString(e), grid);
#endif
}
```
